# Optimizing an MI355X kernel written in HIP

```python
import numpy as np
import jax, jax.numpy as jnp
from jax import lax

D_MODEL = 2048
BATCH = 8
SEQ = 2048
DEPTH = 2

CHUNK = 64
LEFT_CHUNKS = 8
BAND = (LEFT_CHUNKS + 1) * CHUNK
HEAD_DIM = 128
N_HEADS_TOTAL = D_MODEL // HEAD_DIM
N_HEADS_MEM = 4
N_HEADS_MAIN = N_HEADS_TOTAL - N_HEADS_MEM
W_MAIN = N_HEADS_MAIN * HEAD_DIM
W_MEM = N_HEADS_MEM * HEAD_DIM
N_MEM = 256
D_FF = 4 * D_MODEL
REL_CLIP = 256
Q_BLOCK = 128
N_A = DEPTH // 2
N_B = DEPTH - N_A
EPS = 1e-6

kernel_name = "yoco_chunked_relpos_stickbreaking_memory_block"


def rms_norm(x, g):
    xf = x.astype(jnp.float32)
    y = xf * lax.rsqrt(jnp.mean(xf * xf, axis=-1, keepdims=True) + EPS)
    return (y * g.astype(jnp.float32)).astype(x.dtype)


def split_heads(t, n_heads):
    return t.reshape(t.shape[:-1] + (n_heads, HEAD_DIM))


def rel_index():
    a = np.arange(CHUNK)[:, None, None]
    i = np.arange(LEFT_CHUNKS + 1)[None, :, None]
    b = np.arange(CHUNK)[None, None, :]
    dist = (LEFT_CHUNKS - i) * CHUNK + a - b
    return (np.clip(dist, -REL_CLIP, REL_CLIP) + REL_CLIP).reshape(CHUNK, BAND)


def chunk_band_attention(q, k, v, rel_table):
    B, S, H, Dh = q.shape
    nc = S // CHUNK
    pad = ((0, 0), (LEFT_CHUNKS, 0), (0, 0), (0, 0), (0, 0))
    qc = q.reshape(B, nc, CHUNK, H, Dh)
    kc = jnp.pad(k.reshape(B, nc, CHUNK, H, Dh), pad)
    vc = jnp.pad(v.reshape(B, nc, CHUNK, H, Dh), pad)
    scale = HEAD_DIM ** -0.5
    scores = jnp.concatenate(
        [jnp.einsum('bnqhd,bnkhd->bhnqk', qc, kc[:, i:i + nc]) for i in range(LEFT_CHUNKS + 1)],
        axis=-1).astype(jnp.float32) * scale
    bias = jnp.transpose(rel_table[jnp.asarray(rel_index())], (2, 0, 1)).astype(jnp.float32)
    chunk_id = np.arange(nc)[:, None]
    offset = np.repeat(np.arange(LEFT_CHUNKS + 1), CHUNK)[None, :]
    valid = jnp.asarray(chunk_id - LEFT_CHUNKS + offset >= 0)
    scores = jnp.where(valid[None, None, :, None, :], scores + bias[None, :, None], -jnp.inf)
    p = jax.nn.softmax(scores, axis=-1).astype(v.dtype)
    p = p.reshape(B, H, nc, CHUNK, LEFT_CHUNKS + 1, CHUNK)
    out = jnp.einsum('bhnqk,bnkhd->bnqhd', p[..., 0, :], vc[:, 0:nc])
    for i in range(1, LEFT_CHUNKS + 1):
        out = out + jnp.einsum('bhnqk,bnkhd->bnqhd', p[..., i, :], vc[:, i:i + nc])
    return out.reshape(B, S, H * Dh)


def stick_breaking_attention(q, k, v):
    B, S, H, Dh = q.shape
    scale = HEAD_DIM ** -0.5
    outs = []
    for s0 in range(0, S, Q_BLOCK):
        s1 = s0 + Q_BLOCK
        z = jnp.einsum('bqhd,bkhd->bhqk', q[:, s0:s1], k[:, :s1]).astype(jnp.float32) * scale
        t_idx = s0 + jnp.arange(Q_BLOCK)[:, None]
        s_idx = jnp.arange(s1)[None, :]
        causal = s_idx < t_idx
        sp = jnp.where(causal, jax.nn.softplus(z), 0.0)
        stick = lax.cumsum(sp, axis=3, reverse=True) - sp
        a = jnp.where(causal, jnp.exp(jax.nn.log_sigmoid(z) - stick), 0.0).astype(v.dtype)
        outs.append(jnp.einsum('bhqk,bkhd->bqhd', a, v[:, :s1]))
    return jnp.concatenate(outs, axis=1).reshape(B, S, H * Dh)


def memory_attention(qm, mem_n, w_kv, g_q, g_k):
    B, S = qm.shape[0], qm.shape[1]
    kv = mem_n @ w_kv
    km = rms_norm(split_heads(kv[..., :W_MEM], N_HEADS_MEM), g_k)
    vm = split_heads(kv[..., W_MEM:], N_HEADS_MEM)
    qm = rms_norm(qm, g_q)
    s = jnp.einsum('bqhd,bkhd->bhqk', qm, km).astype(jnp.float32) * (HEAD_DIM ** -0.5)
    p = jax.nn.softmax(s, axis=-1).astype(vm.dtype)
    return jnp.einsum('bhqk,bkhd->bqhd', p, vm).reshape(B, S, W_MEM)


def sq_relu_mlp(h, g, w_in, w_out):
    return jnp.square(jax.nn.relu(rms_norm(h, g) @ w_in)) @ w_out


def setup_inputs(seed: int = 0) -> dict:
    key = jax.random.key(seed)
    ks = jax.random.split(key, 16)
    f32 = jnp.float32
    nrm = lambda k, shape, s: jax.random.normal(k, shape, f32) * s
    gain = lambda k, shape: 1.0 + 0.05 * jax.random.normal(k, shape, f32)
    return {
        "x": nrm(ks[0], (BATCH, SEQ, D_MODEL), 1.0),
        "mem": nrm(ks[1], (BATCH, N_MEM, D_MODEL), 1.0),
        "norm_attn": gain(ks[2], (DEPTH, D_MODEL)),
        "norm_mem": gain(ks[3], (DEPTH, D_MODEL)),
        "norm_mlp": gain(ks[4], (DEPTH, D_MODEL)),
        "w_in_a": nrm(ks[5], (N_A, D_MODEL, 3 * W_MAIN + W_MEM), D_MODEL ** -0.5),
        "qk_gain_a": gain(ks[6], (N_A, 2, HEAD_DIM)),
        "rel_bias": nrm(ks[7], (N_A, 2 * REL_CLIP + 1, N_HEADS_MAIN), 0.1),
        "norm_kv": gain(ks[8], (D_MODEL,)),
        "w_kv_shared": nrm(ks[9], (D_MODEL, 2 * W_MAIN), D_MODEL ** -0.5),
        "w_q_b": nrm(ks[10], (N_B, D_MODEL, W_MAIN + W_MEM), D_MODEL ** -0.5),
        "w_mem_kv": nrm(ks[11], (DEPTH, D_MODEL, 2 * W_MEM), D_MODEL ** -0.5),
        "qk_gain_mem": gain(ks[12], (DEPTH, 2, HEAD_DIM)),
        "w_o": nrm(ks[13], (DEPTH, D_MODEL, D_MODEL), D_MODEL ** -0.5),
        "w_mlp_in": nrm(ks[14], (DEPTH, D_MODEL, D_FF), D_MODEL ** -0.5),
        "w_mlp_out": nrm(ks[15], (DEPTH, D_FF, D_MODEL), D_FF ** -0.5),
    }


def reference(x, mem, norm_attn, norm_mem, norm_mlp, w_in_a, qk_gain_a, rel_bias,
              norm_kv, w_kv_shared, w_q_b, w_mem_kv, qk_gain_mem, w_o, w_mlp_in, w_mlp_out):
    h = x
    k_sb = None
    v_sb = None
    for layer in range(DEPTH):
        xn = rms_norm(h, norm_attn[layer])
        mem_n = rms_norm(mem, norm_mem[layer])
        if layer < N_A:
            proj = xn @ w_in_a[layer]
            q = rms_norm(split_heads(proj[..., :W_MAIN], N_HEADS_MAIN), qk_gain_a[layer, 0])
            k = rms_norm(split_heads(proj[..., W_MAIN:2 * W_MAIN], N_HEADS_MAIN), qk_gain_a[layer, 1])
            v = split_heads(proj[..., 2 * W_MAIN:3 * W_MAIN], N_HEADS_MAIN)
            y_main = chunk_band_attention(q, k, v, rel_bias[layer])
            qm = proj[..., 3 * W_MAIN:]
        else:
            if layer == N_A:
                kv = rms_norm(h, norm_kv) @ w_kv_shared
                k_sb = split_heads(kv[..., :W_MAIN], N_HEADS_MAIN)
                v_sb = split_heads(kv[..., W_MAIN:], N_HEADS_MAIN)
            proj = xn @ w_q_b[layer - N_A]
            q = split_heads(proj[..., :W_MAIN], N_HEADS_MAIN)
            y_main = stick_breaking_attention(q, k_sb, v_sb)
            qm = proj[..., W_MAIN:]
        y_mem = memory_attention(split_heads(qm, N_HEADS_MEM), mem_n, w_mem_kv[layer],
                                 qk_gain_mem[layer, 0], qk_gain_mem[layer, 1])
        h = h + jnp.concatenate([y_main, y_mem], axis=-1) @ w_o[layer]
        h = h + sq_relu_mlp(h, norm_mlp[layer], w_mlp_in[layer], w_mlp_out[layer])
    return h
```

```cpp
#include <hip/hip_runtime.h>
#include <hip/hip_cooperative_groups.h>
#include <cstdio>
namespace cg = cooperative_groups;

#define LAS __attribute__((address_space(3)))
#define DI __device__ __forceinline__
typedef unsigned short bf16_t;
typedef short bf16x8 __attribute__((ext_vector_type(8)));
typedef float f32x2 __attribute__((ext_vector_type(2)));
typedef float f32x4 __attribute__((ext_vector_type(4)));
typedef float f32x16 __attribute__((ext_vector_type(16)));
typedef unsigned u32x2 __attribute__((ext_vector_type(2)));
typedef unsigned u32x4 __attribute__((ext_vector_type(4)));
typedef __bf16 bf16v2 __attribute__((ext_vector_type(2)));

constexpr size_t MiB = (size_t)1 << 20;
constexpr size_t OFF_WT_INA    = 0;
constexpr size_t OFF_WT_B1     = 20 * MiB;
constexpr size_t OFF_WT_MEMKV  = 40 * MiB;
constexpr size_t OFF_WT_O      = 48 * MiB;
constexpr size_t OFF_WT_MLPIN  = 64 * MiB;
constexpr size_t OFF_WT_MLPOUT = 128 * MiB;
constexpr size_t OFF_RA        = 192 * MiB;
constexpr size_t OFF_RB        = 256 * MiB;
constexpr size_t OFF_QK        = OFF_RB;
constexpr size_t OFF_VT        = OFF_RB + 112 * MiB;
constexpr size_t OFF_MEMN      = OFF_RB + 160 * MiB;
constexpr size_t OFF_YCAT      = OFF_RB + 176 * MiB;
constexpr size_t OFF_KM        = 512 * MiB;
constexpr size_t OFF_VMT       = 516 * MiB;
constexpr size_t OFF_BIAST     = 520 * MiB;
constexpr size_t OFF_CTR       = 520 * MiB + 32768;
constexpr size_t OFF_BAR       = OFF_CTR + 1024;
constexpr size_t OFF_SS        = OFF_CTR + 16384;
constexpr size_t ZERO_BYTES    = 16384 + 3 * 16384 * 4;
constexpr size_t WS_NEED       = 520 * MiB + 32768 + 16384 + 3 * 16384 * 4;

constexpr float EPS = 1e-6f;
constexpr float LOG2E = 1.4426950408889634f;
constexpr float LN2 = 0.6931471805599453f;
constexpr float ATT_SCALE = 0.08838834764831845f;
constexpr float SB_DONE = 160.0f;

struct Params {
    const float *x, *mem, *norm_attn, *norm_mem, *norm_mlp, *w_in_a, *qk_gain_a, *rel_bias, *norm_kv, *w_kv_shared, *w_q_b, *w_mem_kv,
        *qk_gain_mem, *w_o, *w_mlp_in, *w_mlp_out;
    float* out;
    unsigned char* ws;
};

DI unsigned pack_bf16(float lo, float hi) { f32x2 f = {lo, hi}; bf16v2 b = __builtin_convertvector(f, bf16v2); return __builtin_bit_cast(unsigned, b); }
template <int CTRL> DI float dpp_f(float x) { return __builtin_bit_cast(float, __builtin_amdgcn_mov_dpp(__builtin_bit_cast(int, x), CTRL, 0xf, 0xf, true)); }
DI float dpp_sum16(float x) { x += dpp_f<0xB1>(x); x += dpp_f<0x4E>(x); x += dpp_f<0x141>(x); x += dpp_f<0x128>(x); return x; }
DI float bf2f(short s) { return __uint_as_float(((unsigned)(unsigned short)s) << 16); }
DI bf16x8 pack8(const float* f) {
    u32x4 p; p.x = pack_bf16(f[0], f[1]); p.y = pack_bf16(f[2], f[3]); p.z = pack_bf16(f[4], f[5]); p.w = pack_bf16(f[6], f[7]);
    return __builtin_bit_cast(bf16x8, p);
}

constexpr int BM = 256, BK = 64, HALF = 128, HTB = HALF * BK * 2, STAGE_BYTES = 8 * HTB;
DI int lds_byte(int r, int c) { const int st = (r >> 4) * 2 + (c >> 5), rr = r & 15, cc = c & 31, ob = rr * 64 + cc * 2; return st * 1024 + (ob ^ (((ob >> 9) & 1) << 5)); }
DI void stage_rc(int b, int& R, int& C) { const int st = b / 1024, sb = b % 1024, swz = sb ^ (((sb >> 9) & 1) << 5); R = (st >> 1) * 16 + swz / 64; C = (st & 1) * 32 + (swz % 64) / 2; }
DI int perm32(int rho) { const int n = rho >> 4, i = rho & 15; return 8 * (i >> 2) + 4 * n + (i & 3); }

struct Unit { const char* A; const char* B; char* out; const char* base; bf16_t* hb; float* ss; int ldc, row0, col0, flag; };

DI void tile_map(int wgid, int nM, int nN, int& pm, int& pn) {
    const int nwg = nM * nN;
    { const int q = nwg / 8, r = nwg % 8, xcd = wgid % 8, off = wgid / 8; wgid = (xcd < r ? xcd * (q + 1) : r * (q + 1) + (xcd - r) * q) + off; }
    const int nig = 8 * nN, gid = wgid / nig, fm = gid * 8, gsz = (nM - fm) < 8 ? (nM - fm) : 8;
    pm = fm + ((wgid % nig) % gsz); pn = (wgid % nig) / gsz;
}
DI void mk_unit(Unit& u, const bf16_t* A, const bf16_t* Bt, int K, int nM, int nN, int wg, void* out, const void* base, int ldc, bf16_t* hb = nullptr, float* ss = nullptr, int flag = 0) {
    int pm, pn; tile_map(wg, nM, nN, pm, pn); u.hb = hb; u.ss = ss; u.flag = flag;
    u.A = (const char*)A + (size_t)pm * 256 * K * 2; u.B = (const char*)Bt + (size_t)pn * 256 * K * 2;
    u.out = (char*)out; u.base = (const char*)base; u.ldc = ldc; u.row0 = pm * 256; u.col0 = pn * 256;
}

template <int PH> DI bool sched_next(const Params& p, int i, Unit& u) {
    const int L = i * (int)gridDim.x + (int)blockIdx.x;
    bf16_t* RA = (bf16_t*)(p.ws + OFF_RA);
    if constexpr (PH == 1) {
        bf16_t* W = (bf16_t*)(p.ws + OFF_WT_INA); bf16_t* WM = (bf16_t*)(p.ws + OFF_WT_MEMKV); bf16_t* memn = (bf16_t*)(p.ws + OFF_MEMN);
        if (L < 896) mk_unit(u, RA, W, 2048, 64, 14, L, p.ws + OFF_QK, nullptr, 3584);
        else if (L < 1280) mk_unit(u, W + (size_t)3584 * 2048, RA, 2048, 6, 64, L - 896, p.ws + OFF_VT, nullptr, 16384);
        else if (L < 1344) {
            int j = L - 1280; const int l = j >> 5; j &= 31;
            if (j < 16) mk_unit(u, memn, WM + (size_t)l * 1024 * 2048, 2048, 8, 2, j, p.ws + OFF_KM + (size_t)l * 2048 * 512 * 2, nullptr, 512);
            else mk_unit(u, WM + (size_t)l * 1024 * 2048 + (size_t)512 * 2048, memn, 2048, 2, 8, j - 16, p.ws + OFF_VMT + (size_t)l * 512 * 2048 * 2, nullptr, 2048);
        } else return false;
        return true;
    } else if constexpr (PH == 8) {
        bf16_t* W = (bf16_t*)(p.ws + OFF_WT_B1);
        float* ss = (float*)(p.ws + OFF_SS) + 16384;
        if (L < 896) mk_unit(u, RA, W, 2048, 64, 14, L, p.ws + OFF_QK, nullptr, 3584, nullptr, ss, 0);
        else if (L < 1280) mk_unit(u, W + (size_t)3584 * 2048, RA, 2048, 6, 64, L - 896, p.ws + OFF_VT, nullptr, 16384, nullptr, ss, 1);
        else return false;
        return true;
    } else if constexpr (PH == 3 || PH == 10) {
        constexpr int l = PH == 3 ? 0 : 1;
        if (L >= 512) return false;
        mk_unit(u, (bf16_t*)(p.ws + OFF_YCAT), (bf16_t*)(p.ws + OFF_WT_O) + (size_t)l * 2048 * 2048, 2048, 64, 8, L, p.out, l == 0 ? (const void*)p.x : (const void*)RA, 2048,
                RA, (float*)(p.ws + OFF_SS) + (l == 0 ? 0 : 2 * 16384), l == 0 ? 0 : 1);
        return true;
    } else if constexpr (PH == 5 || PH == 12) {
        constexpr int l = PH == 5 ? 0 : 1;
        if (L >= 2048) return false;
        mk_unit(u, RA, (bf16_t*)(p.ws + OFF_WT_MLPIN) + (size_t)l * 8192 * 2048, 2048, 64, 32, L, p.ws + OFF_RB, nullptr, 8192, nullptr, (float*)(p.ws + OFF_SS) + (l == 0 ? 0 : 2 * 16384));
        return true;
    } else {
        constexpr int l = PH == 6 ? 0 : 1;
        if (L >= 512) return false;
        mk_unit(u, (bf16_t*)(p.ws + OFF_RB), (bf16_t*)(p.ws + OFF_WT_MLPOUT) + (size_t)l * 2048 * 8192, 8192, 64, 8, L, p.out, RA, 2048,
                l == 0 ? RA : nullptr, l == 0 ? (float*)(p.ws + OFF_SS) + 16384 : nullptr, l == 0 ? 1 : 3);
        return true;
    }
}

DI float rs_of(float ssv) { return rsqrtf(ssv * (1.0f / 2048.0f) + EPS); }
template <int MODE>
DI void epilogue(const f32x4 (&acc)[2][2][4][2], const Unit& u, int wr, int wc, int fr, int fq, const float (&ssr)[8]) {
    const int row0 = u.row0 + wr * 64 + fr, col0 = u.col0 + wc * 32 + 8 * fq;
    f32x4 cs[2][2];
    float rrs[8];
    if constexpr (MODE == 3) {
        if (u.flag) {
#pragma unroll
            for (int bj = 0; bj < 2; ++bj)
#pragma unroll
                for (int n = 0; n < 2; ++n) { const f32x4 t = *(const f32x4*)(u.ss + col0 + bj * HALF + 4 * n);
#pragma unroll
                    for (int j = 0; j < 4; ++j) cs[bj][n][j] = rs_of(t[j]); }
        } else {
#pragma unroll
            for (int it = 0; it < 8; ++it) rrs[it] = rs_of(ssr[it]);
        }
    }
    float qs[8];
#pragma unroll
    for (int it = 0; it < 8; ++it) qs[it] = 0.f;
    const bool bbf = (u.flag & 1) != 0;
    u32x4 nb[2]; f32x4 nf[2][2];
    if constexpr (MODE == 2) {
        const size_t roff = (size_t)row0 * u.ldc + col0;
        if (bbf) { nb[0] = *(const u32x4*)((const bf16_t*)u.base + roff); nb[1] = *(const u32x4*)((const bf16_t*)u.base + roff + HALF); }
        else { const float* bp = (const float*)u.base + roff; nf[0][0] = *(const f32x4*)bp; nf[0][1] = *(const f32x4*)(bp + 4); nf[1][0] = *(const f32x4*)(bp + HALF); nf[1][1] = *(const f32x4*)(bp + HALF + 4); }
    }
#pragma unroll
    for (int ai = 0; ai < 2; ++ai)
#pragma unroll
        for (int m = 0; m < 4; ++m) {
            const int it = ai * 4 + m;
            const int row = row0 + ai * HALF + m * 16;
            const size_t roff = (size_t)row * u.ldc + col0;
            float rr = 1.f; float& q = qs[it];
            if constexpr (MODE == 3) { if (!u.flag) rr = rrs[it]; }
            u32x4 cb[2]; f32x4 cf[2][2];
            if constexpr (MODE == 2) {
                cb[0] = nb[0]; cb[1] = nb[1]; cf[0][0] = nf[0][0]; cf[0][1] = nf[0][1]; cf[1][0] = nf[1][0]; cf[1][1] = nf[1][1];
                if (it < 7) {
                    const int nrow = row0 + ((it + 1) >> 2) * HALF + ((it + 1) & 3) * 16;
                    const size_t nroff = (size_t)nrow * u.ldc + col0;
                    if (bbf) { nb[0] = *(const u32x4*)((const bf16_t*)u.base + nroff); nb[1] = *(const u32x4*)((const bf16_t*)u.base + nroff + HALF); }
                    else { const float* bp = (const float*)u.base + nroff; nf[0][0] = *(const f32x4*)bp; nf[0][1] = *(const f32x4*)(bp + 4); nf[1][0] = *(const f32x4*)(bp + HALF); nf[1][1] = *(const f32x4*)(bp + HALF + 4); }
                }
            }
#pragma unroll
            for (int bj = 0; bj < 2; ++bj) {
                f32x4 v0 = acc[ai][bj][m][0], v1 = acc[ai][bj][m][1];
                if constexpr (MODE == 2) {
                    if (bbf) {
                        const u32x4 bb = cb[bj];
                        v0[0] += __uint_as_float(bb.x << 16); v0[1] += __uint_as_float(bb.x & 0xffff0000u); v0[2] += __uint_as_float(bb.y << 16); v0[3] += __uint_as_float(bb.y & 0xffff0000u);
                        v1[0] += __uint_as_float(bb.z << 16); v1[1] += __uint_as_float(bb.z & 0xffff0000u); v1[2] += __uint_as_float(bb.w << 16); v1[3] += __uint_as_float(bb.w & 0xffff0000u);
                    } else { v0 += cf[bj][0]; v1 += cf[bj][1]; }
                    if (u.flag & 2) { float* op = (float*)u.out + roff + bj * HALF; *(f32x4*)op = v0; *(f32x4*)(op + 4) = v1; }
                    if (u.hb) {
                        u32x4 w; w.x = pack_bf16(v0[0], v0[1]); w.y = pack_bf16(v0[2], v0[3]); w.z = pack_bf16(v1[0], v1[1]); w.w = pack_bf16(v1[2], v1[3]);
                        *(u32x4*)(u.hb + roff + bj * HALF) = w;
#pragma unroll
                        for (int j = 0; j < 4; ++j) q += v0[j] * v0[j] + v1[j] * v1[j];
                    }
                } else {
                    if constexpr (MODE == 3) {
                        if (u.flag) { v0 *= cs[bj][0]; v1 *= cs[bj][1]; } else { v0 *= rr; v1 *= rr; }
                    }
                    u32x4 w; w.x = pack_bf16(v0[0], v0[1]); w.y = pack_bf16(v0[2], v0[3]); w.z = pack_bf16(v1[0], v1[1]); w.w = pack_bf16(v1[2], v1[3]);
                    *(u32x4*)((bf16_t*)u.out + roff + bj * HALF) = w;
                }
            }
        }
    if constexpr (MODE == 2) {
        if (u.hb) {
#pragma unroll
            for (int it = 0; it < 8; ++it) qs[it] += __shfl_xor(qs[it], 16);
#pragma unroll
            for (int it = 0; it < 8; ++it) qs[it] += __shfl_xor(qs[it], 32);
            if (fq == 0) {
#pragma unroll
                for (int it = 0; it < 8; ++it) unsafeAtomicAdd(u.ss + row0 + (it >> 2) * HALF + (it & 3) * 16, qs[it]);
            }
        }
    }
}

constexpr int EPI_OFF = STAGE_BYTES + 256, EPI_ROW_B = 144, EPI_WAVE_B = 16 * EPI_ROW_B;
DI void epilogue_rows(const f32x4 (&acc)[2][2][4][2], const Unit& u, int wr, int wc, int fr, int fq, LAS unsigned char* patch, int lane, const float (&ssr)[8]) {
    const int row0 = u.row0 + wr * 64, col0 = u.col0 + wc * 64;
    float rrs[8];
#pragma unroll
    for (int it = 0; it < 8; ++it) { const float t = rs_of(ssr[it]); rrs[it] = t * t; }
#pragma unroll
    for (int ai = 0; ai < 2; ++ai)
#pragma unroll
        for (int m = 0; m < 4; ++m) {
            const int rbase = row0 + ai * HALF + m * 16;
            const float rr = rrs[ai * 4 + m];
#pragma unroll
            for (int bj = 0; bj < 2; ++bj) {
                f32x4 v0 = acc[ai][bj][m][0], v1 = acc[ai][bj][m][1];
#pragma unroll
                for (int j = 0; j < 4; ++j) { float a = fmaxf(v0[j], 0.f), b = fmaxf(v1[j], 0.f); v0[j] = a * a * rr; v1[j] = b * b * rr; }
                u32x4 w; w.x = pack_bf16(v0[0], v0[1]); w.y = pack_bf16(v0[2], v0[3]); w.z = pack_bf16(v1[0], v1[1]); w.w = pack_bf16(v1[2], v1[3]);
                *(LAS u32x4*)(patch + fr * EPI_ROW_B + (32 * bj + 8 * fq) * 2) = w;
            }
#pragma unroll
            for (int i = 0; i < 2; ++i) {
                const int pc = lane + 64 * i, row = pc >> 3, ch = pc & 7;
                const u32x4 w = *(const LAS u32x4*)(patch + row * EPI_ROW_B + ch * 16);
                __builtin_nontemporal_store(w, (u32x4*)((bf16_t*)u.out + (size_t)(rbase + row) * u.ldc + col0 + ch * 8));
            }
        }
}

template <int K, int MODE, int PH>
DI void gemm_phase(LAS unsigned char* lds, const Params& p) {
    int tid = threadIdx.x; asm volatile("" : "+v"(tid));
    const int wid = __builtin_amdgcn_readfirstlane(tid >> 6), lane = tid & 63, wr = wid >> 2, wc = wid & 3, fr = lane & 15, fq = lane >> 4;
    constexpr int nt = K / BK;
    constexpr bool REMAP = (MODE == 1);
    unsigned voffA[2], voffB0[2], voffB1[2];
#pragma unroll
    for (int i = 0; i < 2; ++i) { int R, C; stage_rc(tid * 16 + i * 8192, R, C);
        voffA[i] = (unsigned)(R * K + C) * 2u;
        if constexpr (REMAP) { const int Rb = 64 * (R >> 5) + perm32(R & 31); voffB0[i] = (unsigned)(Rb * K + C) * 2u; voffB1[i] = (unsigned)((Rb + 32) * K + C) * 2u; }
        else { const int Rb = (R & ~31) + perm32(R & 31); voffB0[i] = (unsigned)(Rb * K + C) * 2u; voffB1[i] = (unsigned)((Rb + HALF) * K + C) * 2u; } }
    constexpr size_t kstep = (size_t)(BK * 2);
    constexpr size_t hstep = (size_t)HALF * K * 2;
    const unsigned ldsw = (unsigned)wid * 1024u;
    const int aoff = lds_byte(wr * 64 + fr, fq * 8), boff = lds_byte(wc * 32 + fr, fq * 8);
#define PG8_SA(b, h) (((b) * 2 + (h)) * HTB)
#define PG8_SB(b, h) ((4 + (b) * 2 + (h)) * HTB)
#define PG8_STAGE(bufoff, gbase, voff) do { _Pragma("unroll") for (int _i = 0; _i < 2; ++_i) \
        __builtin_amdgcn_global_load_lds((const unsigned*)((const char*)(gbase) + (voff)[_i]), (LAS unsigned*)(lds + (bufoff) + ldsw + _i * 8192), 16, 0, 0); } while (0)
#define PG8_LDA(dst, b, h) do { _Pragma("unroll") for (int m = 0; m < 4; ++m) _Pragma("unroll") for (int k = 0; k < 2; ++k) dst[m][k] = *(const LAS bf16x8*)(lds + PG8_SA(b, h) + aoff + m * 2048 + k * 1024); } while (0)
#define PG8_LDB(dst, b, h) do { _Pragma("unroll") for (int n = 0; n < 2; ++n) _Pragma("unroll") for (int k = 0; k < 2; ++k) dst[n][k] = *(const LAS bf16x8*)(lds + PG8_SB(b, h) + boff + n * 2048 + k * 1024); } while (0)
#define PG8_MMA(ai, bj, At, Bt) do { __builtin_amdgcn_s_setprio(1); _Pragma("unroll") for (int m = 0; m < 4; ++m) _Pragma("unroll") for (int n = 0; n < 2; ++n) _Pragma("unroll") for (int k = 0; k < 2; ++k) \
        acc[ai][bj][m][n] = __builtin_amdgcn_mfma_f32_16x16x32_bf16(Bt[n][k], At[m][k], acc[ai][bj][m][n], 0, 0, 0); __builtin_amdgcn_s_setprio(0); } while (0)
#define PG8_WAIT_V(n) asm volatile("s_waitcnt vmcnt(" #n ")" ::: "memory")
#define PG8_WAIT_L(n) asm volatile("s_waitcnt lgkmcnt(" #n ")" ::: "memory")
#define PG8_BAR __builtin_amdgcn_s_barrier()
#define PG8_SCHED __builtin_amdgcn_sched_barrier(0)
    Unit cur, nxt; int ui = 0;
    if (!sched_next<PH>(p, 0, cur)) return;
    f32x4 acc[2][2][4][2];
#pragma unroll
    for (int a = 0; a < 2; ++a)
#pragma unroll
        for (int b = 0; b < 2; ++b)
#pragma unroll
            for (int m = 0; m < 4; ++m)
#pragma unroll
                for (int n = 0; n < 2; ++n) acc[a][b][m][n] = (f32x4){0.f, 0.f, 0.f, 0.f};
    bf16x8 At[4][2], B0[2][2], B1[2][2];
    const char* cA = cur.A; const char* cB = cur.B;
    PG8_STAGE(PG8_SB(0, 0), cB, voffB0); PG8_STAGE(PG8_SA(0, 0), cA, voffA); PG8_STAGE(PG8_SB(0, 1), cB, voffB1); PG8_STAGE(PG8_SA(0, 1), cA + hstep, voffA);
    if (wr == 1) PG8_BAR;
    PG8_WAIT_V(4); PG8_BAR;
    PG8_STAGE(PG8_SB(1, 0), cB + kstep, voffB0); PG8_STAGE(PG8_SA(1, 0), cA + kstep, voffA); PG8_STAGE(PG8_SB(1, 1), cB + kstep, voffB1);
    PG8_WAIT_V(6); PG8_BAR;
    for (;;) {
        const bool has_next = sched_next<PH>(p, ui + 1, nxt);
        float ssr[8];
        if constexpr (MODE == 1 || MODE == 3) {
            if (MODE == 1 || !cur.flag) {
#pragma unroll
                for (int it = 0; it < 8; ++it) ssr[it] = cur.ss[cur.row0 + wr * 64 + (it >> 2) * HALF + (it & 3) * 16 + fr];
            } else {
#pragma unroll
                for (int it = 0; it < 8; ++it) ssr[it] = 0.f;
            }
        } else {
#pragma unroll
            for (int it = 0; it < 8; ++it) ssr[it] = 0.f;
        }
        const char* nA = has_next ? nxt.A : cA; const char* nB = has_next ? nxt.B : cB;
        for (int t = 0; t < nt; t += 2) {
            const bool last = (t == nt - 2);
            const char* a1 = cA + (size_t)(t + 1) * kstep;
            const char* a2 = last ? nA : cA + (size_t)(t + 2) * kstep; const char* b2 = last ? nB : cB + (size_t)(t + 2) * kstep;
            const char* a3 = a2 + kstep; const char* b3 = b2 + kstep;
            PG8_LDB(B0, 0, 0); PG8_SCHED; PG8_LDA(At, 0, 0); PG8_STAGE(PG8_SA(1, 1), a1 + hstep, voffA);
            PG8_WAIT_L(8); PG8_BAR; PG8_WAIT_L(0); PG8_MMA(0, 0, At, B0); PG8_BAR; PG8_SCHED;
            PG8_LDB(B1, 0, 1); PG8_STAGE(PG8_SB(0, 0), b2, voffB0);
            PG8_BAR; PG8_WAIT_L(0); PG8_MMA(0, 1, At, B1); PG8_BAR;
            PG8_LDA(At, 0, 1); PG8_STAGE(PG8_SA(0, 0), a2, voffA);
            PG8_BAR; PG8_WAIT_L(0); PG8_MMA(1, 0, At, B0); PG8_BAR; PG8_SCHED;
            PG8_STAGE(PG8_SB(0, 1), b2, voffB1);
            PG8_WAIT_V(6); PG8_BAR; PG8_MMA(1, 1, At, B1); PG8_BAR;
            PG8_LDB(B0, 1, 0); PG8_SCHED; PG8_LDA(At, 1, 0); PG8_STAGE(PG8_SA(0, 1), a2 + hstep, voffA);
            PG8_WAIT_L(8); PG8_BAR; PG8_WAIT_L(0); PG8_MMA(0, 0, At, B0); PG8_BAR; PG8_SCHED;
            PG8_LDB(B1, 1, 1); PG8_STAGE(PG8_SB(1, 0), b3, voffB0);
            PG8_BAR; PG8_WAIT_L(0); PG8_MMA(0, 1, At, B1); PG8_BAR;
            PG8_LDA(At, 1, 1); PG8_STAGE(PG8_SA(1, 0), a3, voffA);
            PG8_BAR; PG8_WAIT_L(0); PG8_MMA(1, 0, At, B0); PG8_BAR; PG8_SCHED;
            PG8_STAGE(PG8_SB(1, 1), b3, voffB1);
            PG8_WAIT_V(6); PG8_BAR; PG8_MMA(1, 1, At, B1); PG8_BAR;
        }
        if constexpr (REMAP) epilogue_rows(acc, cur, wr, wc, fr, fq, lds + EPI_OFF + wid * EPI_WAVE_B, lane, ssr); else epilogue<MODE>(acc, cur, wr, wc, fr, fq, ssr);
        if (!has_next) break;
#pragma unroll
        for (int a = 0; a < 2; ++a)
#pragma unroll
            for (int b = 0; b < 2; ++b)
#pragma unroll
                for (int m = 0; m < 4; ++m)
#pragma unroll
                    for (int n = 0; n < 2; ++n) acc[a][b][m][n] = (f32x4){0.f, 0.f, 0.f, 0.f};
        cur = nxt; cA = nA; cB = nB; ++ui;
    }
    PG8_WAIT_V(0);
    if (wr == 0) PG8_BAR;
    PG8_BAR;
#undef PG8_SA
#undef PG8_SB
#undef PG8_STAGE
#undef PG8_LDA
#undef PG8_LDB
#undef PG8_MMA
#undef PG8_WAIT_V
#undef PG8_WAIT_L
#undef PG8_BAR
#undef PG8_SCHED
}

struct CvtDesc { const float* s; bf16_t* dt; const float* g; int ld, K; };
DI CvtDesc cvt_lookup(const Params& p, int t) {
    const float* src; int ld, K = 2048, nct; bf16_t* dst; const float* gain;
    bf16_t* WA = (bf16_t*)(p.ws + OFF_WT_INA); bf16_t* WB = (bf16_t*)(p.ws + OFF_WT_B1);
    if (t < 384) { src = p.w_in_a; ld = 5120; nct = 24; dst = WA; gain = p.norm_attn; }
    else if ((t -= 384) < 64) { src = p.w_in_a + 4608; ld = 5120; nct = 4; dst = WA + (size_t)3072 * 2048; gain = p.norm_attn; }
    else if ((t -= 64) < 192) { src = p.w_in_a + 3072; ld = 5120; nct = 12; dst = WA + (size_t)3584 * 2048; gain = p.norm_attn; }
    else if ((t -= 192) < 256) { src = p.w_q_b; ld = 2048; nct = 16; dst = WB; gain = p.norm_attn + 2048; }
    else if ((t -= 256) < 384) { src = p.w_kv_shared; ld = 3072; nct = 24; dst = WB + (size_t)2048 * 2048; gain = p.norm_kv; }
    else if ((t -= 384) < 256) { const int l = t >> 7; t &= 127; src = p.w_mem_kv + (size_t)l * 2048 * 1024; ld = 1024; nct = 8;
        dst = (bf16_t*)(p.ws + OFF_WT_MEMKV) + (size_t)l * 1024 * 2048; gain = p.norm_mem + l * 2048; }
    else if ((t -= 256) < 512) { const int l = t >> 8; t &= 255; src = p.w_o + (size_t)l * 2048 * 2048; ld = 2048; nct = 16;
        dst = (bf16_t*)(p.ws + OFF_WT_O) + (size_t)l * 2048 * 2048; gain = nullptr; }
    else if ((t -= 512) < 2048) { const int l = t >> 10; t &= 1023; src = p.w_mlp_in + (size_t)l * 2048 * 8192; ld = 8192; nct = 64;
        dst = (bf16_t*)(p.ws + OFF_WT_MLPIN) + (size_t)l * 8192 * 2048; gain = p.norm_mlp + l * 2048; }
    else { t -= 2048; const int l = t >> 10; t &= 1023; src = p.w_mlp_out + (size_t)l * 8192 * 2048; ld = 2048; K = 8192; nct = 16;
        dst = (bf16_t*)(p.ws + OFF_WT_MLPOUT) + (size_t)l * 2048 * 8192; gain = nullptr; }
    int tid = threadIdx.x; asm volatile("" : "+v"(tid));
    const int w = tid >> 6, lane = tid & 63;
    const int kt0 = (t / nct) * 128, nt0 = (t % nct) * 128, k0 = kt0 + w * 16;
    CvtDesc d; d.s = src + (size_t)k0 * ld + nt0 + lane * 2; d.dt = dst + (size_t)nt0 * K + kt0; d.g = gain ? gain + k0 : nullptr; d.ld = ld; d.K = K;
    return d;
}
DI void cvt_load(const CvtDesc& d, float* a, float* b) {
#pragma unroll
    for (int kk = 0; kk < 16; ++kk) { const f32x2 v = __builtin_nontemporal_load((const f32x2*)(d.s + (size_t)kk * d.ld)); a[kk] = v.x; b[kk] = v.y; }
}
constexpr int CROW_B = 272;
DI void convert_seq(LAS unsigned char* lds, const Params& p, int first, int limit, int stride) {
    if (first >= limit) return;
    int tid = threadIdx.x; asm volatile("" : "+v"(tid));
    const int w = tid >> 6, lane = tid & 63;
    float a[16], b[16];
    CvtDesc d = cvt_lookup(p, first);
    cvt_load(d, a, b);
    for (int t = first; t < limit; t += stride) {
        if (d.g) {
#pragma unroll
            for (int kk = 0; kk < 16; ++kk) { const float g = d.g[kk]; a[kk] *= g; b[kk] *= g; }
        }
        LAS unsigned char* r0 = lds + (2 * lane) * CROW_B + w * 32;
        *(LAS bf16x8*)r0 = pack8(a); *(LAS bf16x8*)(r0 + 16) = pack8(a + 8);
        *(LAS bf16x8*)(r0 + CROW_B) = pack8(b); *(LAS bf16x8*)(r0 + CROW_B + 16) = pack8(b + 8);
        bf16_t* dt = d.dt; const int K = d.K;
        __syncthreads();
        if (t + stride < limit) { d = cvt_lookup(p, t + stride); cvt_load(d, a, b); }
#pragma unroll
        for (int i = 0; i < 4; ++i) {
            const int pc = tid + 512 * i, row = pc >> 4, ch = pc & 15;
            const bf16x8 v = *(const LAS bf16x8*)(lds + row * CROW_B + ch * 16);
            *(bf16x8*)(dt + (size_t)row * K + ch * 8) = v;
        }
        __syncthreads();
    }
}
DI void rowscale(const float* src, bf16_t* dst, int nrows) {
    int tid = threadIdx.x; asm volatile("" : "+v"(tid));
    const int w = tid >> 6, lane = tid & 63;
    for (int row = blockIdx.x * 8 + w; row < nrows; row += gridDim.x * 8) {
        const float* s = src + (size_t)row * 2048;
        f32x4 v[8]; float ss = 0.f;
#pragma unroll
        for (int j = 0; j < 4; ++j) { v[2 * j] = __builtin_nontemporal_load((const f32x4*)(s + (j * 64 + lane) * 8)); v[2 * j + 1] = __builtin_nontemporal_load((const f32x4*)(s + (j * 64 + lane) * 8 + 4)); }
#pragma unroll
        for (int j = 0; j < 8; ++j) ss += v[j][0] * v[j][0] + v[j][1] * v[j][1] + v[j][2] * v[j][2] + v[j][3] * v[j][3];
#pragma unroll
        for (int o = 32; o >= 1; o >>= 1) ss += __shfl_xor(ss, o);
        const float r = rsqrtf(ss * (1.0f / 2048.0f) + EPS);
#pragma unroll
        for (int j = 0; j < 4; ++j) {
            u32x4 o; o.x = pack_bf16(v[2 * j][0] * r, v[2 * j][1] * r); o.y = pack_bf16(v[2 * j][2] * r, v[2 * j][3] * r);
            o.z = pack_bf16(v[2 * j + 1][0] * r, v[2 * j + 1][1] * r); o.w = pack_bf16(v[2 * j + 1][2] * r, v[2 * j + 1][3] * r);
            *(u32x4*)(dst + (size_t)row * 2048 + (j * 64 + lane) * 8) = o;
        }
    }
}

constexpr int KROW_B = 272, VROW_B = 144, KBUF_B = 64 * KROW_B, VBUF_B = 128 * VROW_B, ABUF_B = KBUF_B + VBUF_B, BIAS_OFF = 2 * ABUF_B, OROW_B = 272;
#define MFMA32(a, b, c) __builtin_amdgcn_mfma_f32_32x32x16_bf16((a), (b), (c), 0, 0, 0)

DI void sb_block(const f32x16& st, bool diag, int r, int hh, float& R, float* pv) {
    float sp[16];
    float totA = 0.f, totB = 0.f;
#pragma unroll
    for (int i = 0; i < 16; ++i) {
        const float t = st[i] * (ATT_SCALE * LOG2E);
        const float e = __builtin_amdgcn_exp2f(-fabsf(t));
        float v = fmaxf(t, 0.f) + __builtin_amdgcn_logf(1.0f + e);
        if (diag && !((16 * (i >> 3) + 8 * hh + (i & 7)) < r)) v = 0.f;
        sp[i] = v;
        if (i < 8) totA += v; else totB += v;
    }
    const float oA = __shfl_xor(totA, 32), oB = __shfl_xor(totB, 32);
    float accA = R + (hh == 0 ? (oA + totB + oB) : (oB + totB)), accB = R + (hh == 0 ? oB : 0.f);
#pragma unroll
    for (int i = 7; i >= 0; --i) {
        const float tA = st[i] * (ATT_SCALE * LOG2E), tB = st[8 + i] * (ATT_SCALE * LOG2E);
        float a = __builtin_amdgcn_exp2f(tA - sp[i] - accA), b = __builtin_amdgcn_exp2f(tB - sp[8 + i] - accB);
        accA += sp[i]; accB += sp[8 + i];
        if (diag && !((8 * hh + i) < r)) a = 0.f;
        if (diag && !((16 + 8 * hh + i) < r)) b = 0.f;
        pv[i] = a; pv[8 + i] = b;
    }
    R += (totA + totB) + (oA + oB);
}

template <int MODE>
DI void attn_item(LAS unsigned char* lds, const bf16_t* Qp, int ldq, const bf16_t* Kp, int ldk, const bf16_t* VTp, int ldv, bf16_t* Yp, int q0,
                  const float* gq, const float* gk, const float* biasT_h) {
    int tid = threadIdx.x; asm volatile("" : "+v"(tid));
    const int w = __builtin_amdgcn_readfirstlane(tid >> 6), lane = tid & 63, r = lane & 31, hh = lane >> 5;
    const int rp = (r & ~12) | ((r & 4) << 1) | ((r & 8) >> 1);
    int s_hi, s_lo;
    if constexpr (MODE == 0) { const int n0 = q0 >> 6; s_hi = n0 + 3; s_lo = n0 - 8 > 0 ? n0 - 8 : 0; }
    else if constexpr (MODE == 1) { s_hi = 3; s_lo = 0; }
    else { s_hi = (q0 >> 6) + 3; s_lo = 0; }

    bf16x8 qf[8];
    {
        const bf16_t* qrow = Qp + (size_t)(q0 + w * 32 + r) * ldq + hh * 8;
#pragma unroll
        for (int kk = 0; kk < 8; ++kk) qf[kk] = *(const bf16x8*)(qrow + kk * 16);
        if constexpr (MODE != 2) {
            float ss = 0.f;
#pragma unroll
            for (int kk = 0; kk < 8; ++kk)
#pragma unroll
                for (int j = 0; j < 8; ++j) { const float f = bf2f(qf[kk][j]); ss += f * f; }
            ss += __shfl_xor(ss, 32);
            const float rq = rsqrtf(ss * (1.0f / 128.0f) + EPS) * (ATT_SCALE * LOG2E);
#pragma unroll
            for (int kk = 0; kk < 8; ++kk) {
                const f32x4 g0 = *(const f32x4*)(gq + kk * 16 + hh * 8), g1 = *(const f32x4*)(gq + kk * 16 + hh * 8 + 4);
                float f[8];
#pragma unroll
                for (int j = 0; j < 4; ++j) { f[j] = bf2f(qf[kk][j]) * rq * g0[j]; f[4 + j] = bf2f(qf[kk][4 + j]) * rq * g1[j]; }
                qf[kk] = pack8(f);
            }
        }
    }
    const int krow = tid >> 4, kc16 = tid & 15, vrow = tid >> 3, vc16 = tid & 7;
    f32x4 gk0 = {1.f, 1.f, 1.f, 1.f}, gk1 = gk0;
    if constexpr (MODE != 2) { gk0 = *(const f32x4*)(gk + kc16 * 8); gk1 = *(const f32x4*)(gk + kc16 * 8 + 4); }
    const bf16_t* kg = Kp + (size_t)krow * ldk + kc16 * 8;
    const bf16_t* vg = VTp + (size_t)vrow * ldv + vc16 * 8;
    const unsigned kst = krow * KROW_B + kc16 * 16, vst = KBUF_B + vrow * VROW_B + vc16 * 16;
    if constexpr (MODE == 0) { LAS float* bl = (LAS float*)(lds + BIAS_OFF); for (int i = tid; i < 640; i += 512) bl[i] = biasT_h[i]; }
    LAS int* sbflag = (LAS int*)(lds + BIAS_OFF);
    if constexpr (MODE == 2) { if (tid < 16) sbflag[tid] = 0; }
    bool wave_done = false;

    f32x16 o[4];
#pragma unroll
    for (int d = 0; d < 4; ++d)
#pragma unroll
        for (int i = 0; i < 16; ++i) o[d][i] = 0.f;
    float m_run = -1e30f, l_run = 0.f, R = 0.f;

    bf16x8 kreg[2], vreg[2];
#pragma unroll
    for (int i = 0; i < 2; ++i) { kreg[i] = *(const bf16x8*)(kg + (size_t)(s_hi * 64 + i * 32) * ldk); vreg[i] = *(const bf16x8*)(vg + (size_t)(i * 64) * ldv + s_hi * 64); }
    for (int s = s_hi; s >= s_lo; --s) {
        const int buf = (s_hi - s) & 1;
        LAS unsigned char* B = lds + buf * ABUF_B;
#pragma unroll
        for (int i = 0; i < 2; ++i) {
            if constexpr (MODE != 2) {
                float f[8]; float ss = 0.f;
#pragma unroll
                for (int j = 0; j < 8; ++j) { f[j] = bf2f(kreg[i][j]); ss += f[j] * f[j]; }
                ss = dpp_sum16(ss);
                const float rk = rsqrtf(ss * (1.0f / 128.0f) + EPS);
#pragma unroll
                for (int j = 0; j < 4; ++j) { f[j] *= rk * gk0[j]; f[4 + j] *= rk * gk1[j]; }
                kreg[i] = pack8(f);
            }
            *(LAS bf16x8*)(B + kst + i * 32 * KROW_B) = kreg[i]; *(LAS bf16x8*)(B + vst + i * 64 * VROW_B) = vreg[i];
        }
        __syncthreads();
        if constexpr (MODE == 2) {
            int alldone = 1;
#pragma unroll
            for (int i = 0; i < 8; ++i) alldone &= sbflag[buf * 8 + i];
            if (alldone) break;
        }
        if (s > s_lo) {
#pragma unroll
            for (int i = 0; i < 2; ++i) { kreg[i] = *(const bf16x8*)(kg + (size_t)((s - 1) * 64 + i * 32) * ldk); vreg[i] = *(const bf16x8*)(vg + (size_t)(i * 64) * ldv + (s - 1) * 64); }
        }
        bool active;
        if constexpr (MODE == 0) { const int c = (q0 >> 6) + (w >> 1); active = (s >= c - 8) && (s <= c); }
        else if constexpr (MODE == 1) active = true;
        else active = (s <= (q0 >> 6) + (w >> 1)) && !wave_done;
        if (active) {
            float pv[32];
            bool both = true;
            if constexpr (MODE == 2) both = (2 * s + 1) <= (q0 >> 5) + w;
            const LAS unsigned char* Kb = B + rp * KROW_B + hh * 16;
            const LAS unsigned char* Vb = B + KBUF_B + r * VROW_B + hh * 16;
            f32x16 st0, st1;
#pragma unroll
            for (int i = 0; i < 16; ++i) { st0[i] = 0.f; st1[i] = 0.f; }
            if (both) {
                bf16x8 fa[8], fb[8];
#pragma unroll
                for (int kk = 0; kk < 8; ++kk) fa[kk] = *(const LAS bf16x8*)(Kb + kk * 32);
                __builtin_amdgcn_sched_barrier(0);
#pragma unroll
                for (int kk = 0; kk < 8; ++kk) fb[kk] = *(const LAS bf16x8*)(Kb + 32 * KROW_B + kk * 32);
#pragma unroll
                for (int kk = 0; kk < 8; ++kk) st0 = MFMA32(fa[kk], qf[kk], st0);
                __builtin_amdgcn_sched_barrier(0);
                constexpr int JA = (MODE == 2) ? 1 : 0, JB = 1 - JA;
#pragma unroll
                for (int d = 0; d < 4; ++d)
#pragma unroll
                    for (int ks = 0; ks < 2; ++ks) fa[d * 2 + ks] = *(const LAS bf16x8*)(Vb + d * 32 * VROW_B + JA * 64 + ks * 32);
#pragma unroll
                for (int kk = 0; kk < 8; ++kk) st1 = MFMA32(fb[kk], qf[kk], st1);
                __builtin_amdgcn_sched_barrier(0);
#define LOAD_FB() do { _Pragma("unroll") for (int d = 0; d < 4; ++d) _Pragma("unroll") for (int ks = 0; ks < 2; ++ks) \
                    fb[d * 2 + ks] = *(const LAS bf16x8*)(Vb + d * 32 * VROW_B + JB * 64 + ks * 32); } while (0)
                if constexpr (MODE != 2) {
                    float sc[32];
                    if constexpr (MODE == 0) {
                        const LAS float* bl = (const LAS float*)(lds + BIAS_OFF) + ((q0 + w * 32 + r) - s * 64 - 8 * hh + 63);
#pragma unroll
                        for (int i = 0; i < 16; ++i) { sc[i] = st0[i] + bl[-(16 * (i >> 3) + (i & 7))]; sc[16 + i] = st1[i] + bl[-(32 + 16 * (i >> 3) + (i & 7))]; }
                    } else {
#pragma unroll
                        for (int i = 0; i < 16; ++i) { sc[i] = st0[i]; sc[16 + i] = st1[i]; }
                    }
                    float mx = sc[0];
#pragma unroll
                    for (int i = 1; i < 32; ++i) mx = fmaxf(mx, sc[i]);
                    mx = fmaxf(mx, __shfl_xor(mx, 32));
                    const float mnew = fmaxf(m_run, mx);
                    if (__any(mnew > m_run)) {
                        const float alpha = __builtin_amdgcn_exp2f(m_run - mnew);
                        l_run *= alpha;
#pragma unroll
                        for (int d = 0; d < 4; ++d)
#pragma unroll
                            for (int i = 0; i < 16; ++i) o[d][i] *= alpha;
                        m_run = mnew;
                    }
                    float ps = 0.f;
#pragma unroll
                    for (int i = 0; i < 32; ++i) { pv[i] = __builtin_amdgcn_exp2f(sc[i] - m_run); ps += pv[i]; }
                    l_run += ps;
                    const bf16x8 pf0 = pack8(pv), pf1 = pack8(pv + 8), pf2 = pack8(pv + 16), pf3 = pack8(pv + 24);
                    __builtin_amdgcn_sched_barrier(0);
                    LOAD_FB();
#pragma unroll
                    for (int d = 0; d < 4; ++d) { o[d] = MFMA32(fa[d * 2], pf0, o[d]); o[d] = MFMA32(fa[d * 2 + 1], pf1, o[d]); }
                    __builtin_amdgcn_sched_barrier(0);
#pragma unroll
                    for (int d = 0; d < 4; ++d) { o[d] = MFMA32(fb[d * 2], pf2, o[d]); o[d] = MFMA32(fb[d * 2 + 1], pf3, o[d]); }
                } else {
                    const int kdiag = (q0 >> 5) + w;
                    sb_block(st1, (2 * s + 1) == kdiag, r, hh, R, pv + 16);
                    const bf16x8 pf2 = pack8(pv + 16), pf3 = pack8(pv + 24);
#pragma unroll
                    for (int d = 0; d < 4; ++d) { o[d] = MFMA32(fa[d * 2], pf2, o[d]); o[d] = MFMA32(fa[d * 2 + 1], pf3, o[d]); }
                    __builtin_amdgcn_sched_barrier(0);
                    sb_block(st0, false, r, hh, R, pv);
                    const bf16x8 pf0 = pack8(pv), pf1 = pack8(pv + 8);
                    __builtin_amdgcn_sched_barrier(0);
                    LOAD_FB();
#pragma unroll
                    for (int d = 0; d < 4; ++d) { o[d] = MFMA32(fb[d * 2], pf0, o[d]); o[d] = MFMA32(fb[d * 2 + 1], pf1, o[d]); }
                }
#undef LOAD_FB
            } else {
                if constexpr (MODE == 2) {
#pragma unroll
                    for (int kk = 0; kk < 8; ++kk) { const bf16x8 kf = *(const LAS bf16x8*)(Kb + kk * 32); st0 = MFMA32(kf, qf[kk], st0); }
                    sb_block(st0, true, r, hh, R, pv);
                    const bf16x8 pf0 = pack8(pv), pf1 = pack8(pv + 8);
#pragma unroll
                    for (int d = 0; d < 4; ++d) {
                        const bf16x8 v0 = *(const LAS bf16x8*)(Vb + d * 32 * VROW_B), v1 = *(const LAS bf16x8*)(Vb + d * 32 * VROW_B + 32);
                        o[d] = MFMA32(v0, pf0, o[d]); o[d] = MFMA32(v1, pf1, o[d]);
                    }
                }
            }
            if constexpr (MODE == 2) { if (__all(R >= SB_DONE)) wave_done = true; }
        }
        if constexpr (MODE == 2) { if (lane == 0) sbflag[(buf ^ 1) * 8 + w] = wave_done ? 1 : 0; }
    }
    float inv = 1.f;
    if constexpr (MODE != 2) { const float lt = l_run + __shfl_xor(l_run, 32); inv = 1.0f / lt; }
    __syncthreads();
    LAS unsigned char* ob = lds + w * (32 * OROW_B);
#pragma unroll
    for (int d = 0; d < 4; ++d)
#pragma unroll
        for (int g = 0; g < 4; ++g) {
            u32x2 v; v.x = pack_bf16(o[d][4 * g] * inv, o[d][4 * g + 1] * inv); v.y = pack_bf16(o[d][4 * g + 2] * inv, o[d][4 * g + 3] * inv);
            *(LAS u32x2*)(ob + r * OROW_B + (d * 32 + 8 * g + 4 * hh) * 2) = v;
        }
    __syncthreads();
#pragma unroll
    for (int i = 0; i < 8; ++i) {
        const int pc = lane + 64 * i, row = pc >> 4, ch = pc & 15;
        const bf16x8 v = *(const LAS bf16x8*)(ob + row * OROW_B + ch * 16);
        *(bf16x8*)(Yp + (size_t)(q0 + w * 32 + row) * 2048 + ch * 8) = v;
    }
    __syncthreads();
}

DI void mem_item(LAS unsigned char* lds, const Params& p, int l, int j, int qcol0) {
    const int bm = j >> 3, I = j & 7, b = bm >> 2, m = bm & 3;
    const bf16_t* QK = (const bf16_t*)(p.ws + OFF_QK);
    attn_item<1>(lds, QK + (size_t)b * 2048 * 3584 + qcol0 + m * 128, 3584,
                 (const bf16_t*)(p.ws + OFF_KM) + (size_t)l * 2048 * 512 + (size_t)b * 256 * 512 + m * 128, 512,
                 (const bf16_t*)(p.ws + OFF_VMT) + (size_t)l * 512 * 2048 + (size_t)m * 128 * 2048 + b * 256, 2048,
                 (bf16_t*)(p.ws + OFF_YCAT) + (size_t)b * 2048 * 2048 + 1536 + m * 128, I * 256,
                 p.qk_gain_mem + l * 256, p.qk_gain_mem + l * 256 + 128, nullptr);
}


#define XB_TMO      128
#define XB_XCNT(j)  (256  + 64 * (j))
#define XB_XSUB(j)  (1280 + 64 * (j))
#define XB_XGEN(j)  (2304 + 64 * (j))
#define XB_TOP      3328
#define XB_TOPGEN   3392
#define XCD_BAR_WORDS 3456
#define XB_SPIN_CAP (1u << 22)
DI unsigned xb_ld(unsigned* p) { return __hip_atomic_load(p, __ATOMIC_RELAXED, __HIP_MEMORY_SCOPE_AGENT); }
DI unsigned xb_add(unsigned* p, unsigned v) { return __hip_atomic_fetch_add(p, v, __ATOMIC_RELAXED, __HIP_MEMORY_SCOPE_AGENT); }
DI unsigned xb_xcc_id() { return (unsigned)__builtin_amdgcn_s_getreg((3 << 11) | 20) & 0xFu; }
#define XB_SPIN(cond, bar) do { unsigned _sp = 0; while (cond) { __builtin_amdgcn_s_sleep(1); \
    if ((++_sp & 255u) == 0u) { if (xb_ld(&(bar)[XB_TMO])) break; if (_sp > XB_SPIN_CAP) { atomicAdd(&(bar)[XB_TMO], 1u); break; } } } } while (0)
struct XcdBarrier { unsigned* bar; unsigned x; volatile LAS unsigned* st; };
DI XcdBarrier xcd_barrier_post(unsigned* bar, volatile LAS unsigned* st) {
    XcdBarrier b; b.bar = bar; b.x = xb_xcc_id(); b.st = st;
    if (threadIdx.x == 0) (void)xb_add(&bar[XB_XCNT(b.x)], 1u);
    return b;
}
DI void xcd_barrier_complete(unsigned* bar, unsigned x, unsigned& nloc, unsigned& nx) {
    const unsigned G = gridDim.x * gridDim.y * gridDim.z;
    unsigned sum, cnt, mine, sp = 0u;
    for (;;) {
        sum = 0u; cnt = 0u; mine = 0u;
#pragma unroll
        for (unsigned j = 0; j < 16; ++j) { const unsigned c = xb_ld(&bar[XB_XCNT(j)]); sum += c; cnt += (c > 0u) ? 1u : 0u; mine = (j == x) ? c : mine; }
        if (sum == G) break;
        __builtin_amdgcn_s_sleep(1);
        if ((++sp & 255u) == 0u) { if (xb_ld(&bar[XB_TMO])) break; if (sp > XB_SPIN_CAP) { atomicAdd(&bar[XB_TMO], 1u); break; } }
    }
    nloc = mine > 0u ? mine : 1u; nx = cnt > 0u ? cnt : 1u;
}
DI void xcd_barrier(const XcdBarrier& b) {
    asm volatile("s_waitcnt vmcnt(0)" ::: "memory");
    __syncthreads();
    if (threadIdx.x == 0) {
        unsigned* bar = b.bar;
        __builtin_amdgcn_s_waitcnt(0);
        unsigned nloc = b.st[0], nx = b.st[1];
        if (nloc == 0u) { xcd_barrier_complete(bar, b.x, nloc, nx); b.st[0] = nloc; b.st[1] = nx; }
        const unsigned old = xb_add(&bar[XB_XSUB(b.x)], 1u);
        const unsigned gen = old / nloc;
        if (old + 1u == (gen + 1u) * nloc) {
            __builtin_amdgcn_fence(__ATOMIC_RELEASE, "agent");
            asm volatile("s_waitcnt vmcnt(0)" ::: "memory");
            const unsigned og = xb_add(&bar[XB_TOP], 1u);
            const unsigned tg = og / nx;
            if (og + 1u == (tg + 1u) * nx) xb_add(&bar[XB_TOPGEN], 1u);
            else XB_SPIN(xb_ld(&bar[XB_TOPGEN]) == tg, bar);
            __builtin_amdgcn_fence(__ATOMIC_ACQUIRE, "agent");
            xb_add(&bar[XB_XGEN(b.x)], 1u);
            asm volatile("s_waitcnt vmcnt(0)" ::: "memory");
        } else {
            XB_SPIN(xb_ld(&bar[XB_XGEN(b.x)]) == gen, bar);
            __builtin_amdgcn_fence(__ATOMIC_ACQUIRE, "agent");
            asm volatile("s_waitcnt vmcnt(0)" ::: "memory");
        }
    }
    __syncthreads();
}

constexpr int LDS_BYTES = STAGE_BYTES + 256 + 8 * EPI_WAVE_B;

__global__ void __launch_bounds__(512, 2) mega(Params p) {
    extern __shared__ __attribute__((aligned(16))) unsigned char shm_raw[];
    LAS unsigned char* lds = (LAS unsigned char*)shm_raw;
    cg::grid_group grid = cg::this_grid();
    const int tid = threadIdx.x;
    bf16_t* RA = (bf16_t*)(p.ws + OFF_RA);
    unsigned* ctr = (unsigned*)(p.ws + OFF_CTR);
    volatile LAS unsigned* xst = (volatile LAS unsigned*)(lds + STAGE_BYTES);
    if (tid == 0) { xst[0] = 0u; xst[1] = 0u; }
    __syncthreads();
    const XcdBarrier xb = xcd_barrier_post((unsigned*)(p.ws + OFF_BAR), xst);

    convert_seq(lds, p, (int)blockIdx.x, 4096, (int)gridDim.x);
    rowscale(p.x, RA, 16384);
    rowscale(p.mem, (bf16_t*)(p.ws + OFF_MEMN), 2048);
    {
        float* bt = (float*)(p.ws + OFF_BIAST);
        for (int i = blockIdx.x * 512 + tid; i < 12 * 640; i += gridDim.x * 512) {
            const int h = i / 640, idx = i % 640; int dist = idx - 63; if (dist > 256) dist = 256;
            bt[i] = p.rel_bias[(dist + 256) * 12 + h] * LOG2E;
        }
    }
    if (p.ws == nullptr) grid.sync();
    xcd_barrier(xb);
    gemm_phase<2048, 0, 1>(lds, p);
    {
        const int nfree = (int)gridDim.x - 64;
        if (nfree > 0) { if ((int)blockIdx.x >= 64) convert_seq(lds, p, 4096 + (int)blockIdx.x - 64, 6144, nfree); }
        else convert_seq(lds, p, 4096 + (int)blockIdx.x, 6144, (int)gridDim.x);
    }
    xcd_barrier(xb);
    for (int it = blockIdx.x; it < 1024; it += gridDim.x) {
        if (it < 768) {
            const int bh = it >> 3, I = it & 7, b = bh / 12, h = bh % 12;
            const bf16_t* QK = (const bf16_t*)(p.ws + OFF_QK) + (size_t)b * 2048 * 3584;
            attn_item<0>(lds, QK + h * 128, 3584, QK + 1536 + h * 128, 3584,
                         (const bf16_t*)(p.ws + OFF_VT) + (size_t)h * 128 * 16384 + b * 2048, 16384,
                         (bf16_t*)(p.ws + OFF_YCAT) + (size_t)b * 2048 * 2048 + h * 128, I * 256, p.qk_gain_a, p.qk_gain_a + 128, (const float*)(p.ws + OFF_BIAST) + h * 640);
        } else mem_item(lds, p, 0, it - 768, 3072);
    }
    xcd_barrier(xb);
    gemm_phase<2048, 2, 3>(lds, p);
    xcd_barrier(xb);
    gemm_phase<2048, 1, 5>(lds, p);
    xcd_barrier(xb);
    gemm_phase<8192, 2, 6>(lds, p);
    xcd_barrier(xb);
    gemm_phase<2048, 3, 8>(lds, p);
    xcd_barrier(xb);
    for (;;) {
        LAS int* slot = (LAS int*)(lds + STAGE_BYTES + 64);
        if (tid == 0) slot[0] = (int)atomicAdd(ctr, 1u);
        __syncthreads();
        const int it = slot[0];
        __syncthreads();
        if (it >= 1024) break;
        if (it < 768) {
            const int I = 7 - it / 96, bh = it % 96, b = bh / 12, h = bh % 12;
            const bf16_t* QK = (const bf16_t*)(p.ws + OFF_QK) + (size_t)b * 2048 * 3584;
            attn_item<2>(lds, QK + h * 128, 3584, QK + 2048 + h * 128, 3584,
                         (const bf16_t*)(p.ws + OFF_VT) + (size_t)h * 128 * 16384 + b * 2048, 16384,
                         (bf16_t*)(p.ws + OFF_YCAT) + (size_t)b * 2048 * 2048 + h * 128, I * 256, nullptr, nullptr, nullptr);
        } else mem_item(lds, p, 1, it - 768, 1536);
    }
    xcd_barrier(xb);
    gemm_phase<2048, 2, 10>(lds, p);
    xcd_barrier(xb);
    gemm_phase<2048, 1, 12>(lds, p);
    xcd_barrier(xb);
    gemm_phase<8192, 2, 13>(lds, p);
}

extern "C" void kernel_launch(void* const* d_in, const int* in_sizes, int n_in, void* d_out, int out_size, void* d_ws, size_t ws_size, hipStream_t stream) {
    static int grid_blocks = 0;
    if (!grid_blocks) {
        int dev = 0, cus = 0, per_cu = 0;
        hipGetDevice(&dev);
        hipDeviceGetAttribute(&cus, hipDeviceAttributeMultiprocessorCount, dev);
        hipFuncSetAttribute((const void*)mega, hipFuncAttributeMaxDynamicSharedMemorySize, LDS_BYTES);
        hipOccupancyMaxActiveBlocksPerMultiprocessor(&per_cu, mega, 512, LDS_BYTES);
        if (per_cu < 1) per_cu = 1;
        grid_blocks = cus * per_cu;
        if (grid_blocks > 256) grid_blocks = 256;
    }
    if (ws_size < WS_NEED) { fprintf(stderr, "workspace too small: %zu < %zu\n", ws_size, WS_NEED); return; }
    Params p{};
    p.x = (const float*)d_in[0]; p.mem = (const float*)d_in[1]; p.norm_attn = (const float*)d_in[2]; p.norm_mem = (const float*)d_in[3];
    p.norm_mlp = (const float*)d_in[4]; p.w_in_a = (const float*)d_in[5]; p.qk_gain_a = (const float*)d_in[6]; p.rel_bias = (const float*)d_in[7];
    p.norm_kv = (const float*)d_in[8]; p.w_kv_shared = (const float*)d_in[9]; p.w_q_b = (const float*)d_in[10]; p.w_mem_kv = (const float*)d_in[11];
    p.qk_gain_mem = (const float*)d_in[12]; p.w_o = (const float*)d_in[13]; p.w_mlp_in = (const float*)d_in[14]; p.w_mlp_out = (const float*)d_in[15];
    p.out = (float*)d_out; p.ws = (unsigned char*)d_ws;
    (void)hipMemsetAsync((unsigned char*)d_ws + OFF_CTR, 0, ZERO_BYTES, stream);
    void* args[] = {&p};
    hipError_t e = hipLaunchCooperativeKernel((void*)mega, dim3(grid_blocks), dim3(512), args, LDS_BYTES, stream);
    if (e != hipSuccess) fprintf(stderr, "cooperative launch failed: %s (grid %d)\n", hipGetErrorString(e), grid_blocks);
}
```

```cpp
#include <hip/hip_runtime.h>
#include <hip/hip_cooperative_groups.h>
#include <cstdio>
namespace cg = cooperative_groups;

#define LAS __attribute__((address_space(3)))
#define DI __device__ __forceinline__
typedef unsigned short bf16_t;
typedef short bf16x8 __attribute__((ext_vector_type(8)));
typedef float f32x2 __attribute__((ext_vector_type(2)));
typedef float f32x4 __attribute__((ext_vector_type(4)));
typedef float f32x16 __attribute__((ext_vector_type(16)));
typedef unsigned u32x2 __attribute__((ext_vector_type(2)));
typedef unsigned u32x4 __attribute__((ext_vector_type(4)));
typedef __bf16 bf16v2 __attribute__((ext_vector_type(2)));

constexpr size_t MiB = (size_t)1 << 20;
constexpr size_t OFF_WT_INA    = 0;
constexpr size_t OFF_WT_B1     = 20 * MiB;
constexpr size_t OFF_WT_MEMKV  = 40 * MiB;
constexpr size_t OFF_WT_O      = 48 * MiB;
constexpr size_t OFF_WT_MLPIN  = 64 * MiB;
constexpr size_t OFF_WT_MLPOUT = 128 * MiB;
constexpr size_t OFF_RA        = 192 * MiB;
constexpr size_t OFF_RB        = 256 * MiB;
constexpr size_t OFF_QK        = OFF_RB;
constexpr size_t OFF_VT        = OFF_RB + 112 * MiB;
constexpr size_t OFF_MEMN      = OFF_RB + 160 * MiB;
constexpr size_t OFF_YCAT      = OFF_RB + 176 * MiB;
constexpr size_t OFF_KM        = 512 * MiB;
constexpr size_t OFF_VMT       = 516 * MiB;
constexpr size_t OFF_BIAST     = 520 * MiB;
constexpr size_t OFF_CTR       = 520 * MiB + 32768;
constexpr size_t OFF_BAR       = OFF_CTR + 1024;
constexpr size_t OFF_SS        = OFF_CTR + 16384;
constexpr size_t ZERO_BYTES    = 16384 + 3 * 16384 * 4;
constexpr size_t WS_NEED       = 520 * MiB + 32768 + 16384 + 3 * 16384 * 4;

constexpr float EPS = 1e-6f;
constexpr float LOG2E = 1.4426950408889634f;
constexpr float LN2 = 0.6931471805599453f;
constexpr float ATT_SCALE = 0.08838834764831845f;
constexpr float SB_DONE = 160.0f;

struct Params {
    const float *x, *mem, *norm_attn, *norm_mem, *norm_mlp, *w_in_a, *qk_gain_a, *rel_bias, *norm_kv, *w_kv_shared, *w_q_b, *w_mem_kv,
        *qk_gain_mem, *w_o, *w_mlp_in, *w_mlp_out;
    float* out;
    unsigned char* ws;
};

DI unsigned pack_bf16(float lo, float hi) { f32x2 f = {lo, hi}; bf16v2 b = __builtin_convertvector(f, bf16v2); return __builtin_bit_cast(unsigned, b); }
template <int CTRL> DI float dpp_f(float x) { return __builtin_bit_cast(float, __builtin_amdgcn_mov_dpp(__builtin_bit_cast(int, x), CTRL, 0xf, 0xf, true)); }
DI float dpp_sum16(float x) { x += dpp_f<0xB1>(x); x += dpp_f<0x4E>(x); x += dpp_f<0x141>(x); x += dpp_f<0x128>(x); return x; }
DI float bf2f(short s) { return __uint_as_float(((unsigned)(unsigned short)s) << 16); }
DI bf16x8 pack8(const float* f) {
    u32x4 p; p.x = pack_bf16(f[0], f[1]); p.y = pack_bf16(f[2], f[3]); p.z = pack_bf16(f[4], f[5]); p.w = pack_bf16(f[6], f[7]);
    return __builtin_bit_cast(bf16x8, p);
}

constexpr int BM = 256, BK = 64, HALF = 128, HTB = HALF * BK * 2, STAGE_BYTES = 8 * HTB;
DI int lds_byte(int r, int c) { const int st = (r >> 4) * 2 + (c >> 5), rr = r & 15, cc = c & 31, ob = rr * 64 + cc * 2; return st * 1024 + (ob ^ (((ob >> 9) & 1) << 5)); }
DI void stage_rc(int b, int& R, int& C) { const int st = b / 1024, sb = b % 1024, swz = sb ^ (((sb >> 9) & 1) << 5); R = (st >> 1) * 16 + swz / 64; C = (st & 1) * 32 + (swz % 64) / 2; }
DI int perm32(int rho) { const int n = rho >> 4, i = rho & 15; return 8 * (i >> 2) + 4 * n + (i & 3); }

struct Unit { const char* A; const char* B; char* out; const char* base; bf16_t* hb; float* ss; int ldc, row0, col0, flag; };

DI void tile_map(int wgid, int nM, int nN, int& pm, int& pn) {
    const int nwg = nM * nN;
    { const int q = nwg / 8, r = nwg % 8, xcd = wgid % 8, off = wgid / 8; wgid = (xcd < r ? xcd * (q + 1) : r * (q + 1) + (xcd - r) * q) + off; }
    const int nig = 8 * nN, gid = wgid / nig, fm = gid * 8, gsz = (nM - fm) < 8 ? (nM - fm) : 8;
    pm = fm + ((wgid % nig) % gsz); pn = (wgid % nig) / gsz;
}
DI void mk_unit(Unit& u, const bf16_t* A, const bf16_t* Bt, int K, int nM, int nN, int wg, void* out, const void* base, int ldc, bf16_t* hb = nullptr, float* ss = nullptr, int flag = 0) {
    int pm, pn; tile_map(wg, nM, nN, pm, pn); u.hb = hb; u.ss = ss; u.flag = flag;
    u.A = (const char*)A + (size_t)pm * 256 * K * 2; u.B = (const char*)Bt + (size_t)pn * 256 * K * 2;
    u.out = (char*)out; u.base = (const char*)base; u.ldc = ldc; u.row0 = pm * 256; u.col0 = pn * 256;
}

template <int PH> DI bool sched_next(const Params& p, int i, Unit& u) {
    const int L = i * (int)gridDim.x + (int)blockIdx.x;
    bf16_t* RA = (bf16_t*)(p.ws + OFF_RA);
    if constexpr (PH == 1) {
        bf16_t* W = (bf16_t*)(p.ws + OFF_WT_INA); bf16_t* WM = (bf16_t*)(p.ws + OFF_WT_MEMKV); bf16_t* memn = (bf16_t*)(p.ws + OFF_MEMN);
        if (L < 896) mk_unit(u, RA, W, 2048, 64, 14, L, p.ws + OFF_QK, nullptr, 3584);
        else if (L < 1280) mk_unit(u, W + (size_t)3584 * 2048, RA, 2048, 6, 64, L - 896, p.ws + OFF_VT, nullptr, 16384);
        else if (L < 1344) {
            int j = L - 1280; const int l = j >> 5; j &= 31;
            if (j < 16) mk_unit(u, memn, WM + (size_t)l * 1024 * 2048, 2048, 8, 2, j, p.ws + OFF_KM + (size_t)l * 2048 * 512 * 2, nullptr, 512);
            else mk_unit(u, WM + (size_t)l * 1024 * 2048 + (size_t)512 * 2048, memn, 2048, 2, 8, j - 16, p.ws + OFF_VMT + (size_t)l * 512 * 2048 * 2, nullptr, 2048);
        } else return false;
        return true;
    } else if constexpr (PH == 8) {
        bf16_t* W = (bf16_t*)(p.ws + OFF_WT_B1);
        float* ss = (float*)(p.ws + OFF_SS) + 16384;
        if (L < 896) mk_unit(u, RA, W, 2048, 64, 14, L, p.ws + OFF_QK, nullptr, 3584, nullptr, ss, 0);
        else if (L < 1280) mk_unit(u, W + (size_t)3584 * 2048, RA, 2048, 6, 64, L - 896, p.ws + OFF_VT, nullptr, 16384, nullptr, ss, 1);
        else return false;
        return true;
    } else if constexpr (PH == 3 || PH == 10) {
        constexpr int l = PH == 3 ? 0 : 1;
        if (L >= 512) return false;
        mk_unit(u, (bf16_t*)(p.ws + OFF_YCAT), (bf16_t*)(p.ws + OFF_WT_O) + (size_t)l * 2048 * 2048, 2048, 64, 8, L, p.out, l == 0 ? (const void*)p.x : (const void*)RA, 2048,
                RA, (float*)(p.ws + OFF_SS) + (l == 0 ? 0 : 2 * 16384), l == 0 ? 0 : 1);
        return true;
    } else if constexpr (PH == 5 || PH == 12) {
        constexpr int l = PH == 5 ? 0 : 1;
        if (L >= 2048) return false;
        mk_unit(u, RA, (bf16_t*)(p.ws + OFF_WT_MLPIN) + (size_t)l * 8192 * 2048, 2048, 64, 32, L, p.ws + OFF_RB, nullptr, 8192, nullptr, (float*)(p.ws + OFF_SS) + (l == 0 ? 0 : 2 * 16384));
        return true;
    } else {
        constexpr int l = PH == 6 ? 0 : 1;
        if (L >= 512) return false;
        mk_unit(u, (bf16_t*)(p.ws + OFF_RB), (bf16_t*)(p.ws + OFF_WT_MLPOUT) + (size_t)l * 2048 * 8192, 8192, 64, 8, L, p.out, RA, 2048,
                l == 0 ? RA : nullptr, l == 0 ? (float*)(p.ws + OFF_SS) + 16384 : nullptr, l == 0 ? 1 : 3);
        return true;
    }
}

DI float rs_of(float ssv) { return rsqrtf(ssv * (1.0f / 2048.0f) + EPS); }
template <int MODE>
DI void epilogue(const f32x4 (&acc)[2][2][4][2], const Unit& u, int wr, int wc, int fr, int fq, const float (&ssr)[8]) {
    const int row0 = u.row0 + wr * 64 + fr, col0 = u.col0 + wc * 32 + 8 * fq;
    f32x4 cs[2][2];
    float rrs[8];
    if constexpr (MODE == 3) {
        if (u.flag) {
#pragma unroll
            for (int bj = 0; bj < 2; ++bj)
#pragma unroll
                for (int n = 0; n < 2; ++n) { const f32x4 t = *(const f32x4*)(u.ss + col0 + bj * HALF + 4 * n);
#pragma unroll
                    for (int j = 0; j < 4; ++j) cs[bj][n][j] = rs_of(t[j]); }
        } else {
#pragma unroll
            for (int it = 0; it < 8; ++it) rrs[it] = rs_of(ssr[it]);
        }
    }
    const bool bbf = (u.flag & 1) != 0;
    u32x4 nb[2]; f32x4 nf[2][2];
    if constexpr (MODE == 2) {
        const size_t roff = (size_t)row0 * u.ldc + col0;
        if (bbf) { nb[0] = *(const u32x4*)((const bf16_t*)u.base + roff); nb[1] = *(const u32x4*)((const bf16_t*)u.base + roff + HALF); }
        else { const float* bp = (const float*)u.base + roff; nf[0][0] = *(const f32x4*)bp; nf[0][1] = *(const f32x4*)(bp + 4); nf[1][0] = *(const f32x4*)(bp + HALF); nf[1][1] = *(const f32x4*)(bp + HALF + 4); }
    }
#pragma unroll
    for (int ai = 0; ai < 2; ++ai)
#pragma unroll
        for (int m = 0; m < 4; ++m) {
            const int it = ai * 4 + m;
            const int row = row0 + ai * HALF + m * 16;
            const size_t roff = (size_t)row * u.ldc + col0;
            float rr = 1.f, q = 0.f;
            if constexpr (MODE == 3) { if (!u.flag) rr = rrs[it]; }
            u32x4 cb[2]; f32x4 cf[2][2];
            if constexpr (MODE == 2) {
                cb[0] = nb[0]; cb[1] = nb[1]; cf[0][0] = nf[0][0]; cf[0][1] = nf[0][1]; cf[1][0] = nf[1][0]; cf[1][1] = nf[1][1];
                if (it < 7) {
                    const int nrow = row0 + ((it + 1) >> 2) * HALF + ((it + 1) & 3) * 16;
                    const size_t nroff = (size_t)nrow * u.ldc + col0;
                    if (bbf) { nb[0] = *(const u32x4*)((const bf16_t*)u.base + nroff); nb[1] = *(const u32x4*)((const bf16_t*)u.base + nroff + HALF); }
                    else { const float* bp = (const float*)u.base + nroff; nf[0][0] = *(const f32x4*)bp; nf[0][1] = *(const f32x4*)(bp + 4); nf[1][0] = *(const f32x4*)(bp + HALF); nf[1][1] = *(const f32x4*)(bp + HALF + 4); }
                }
            }
#pragma unroll
            for (int bj = 0; bj < 2; ++bj) {
                f32x4 v0 = acc[ai][bj][m][0], v1 = acc[ai][bj][m][1];
                if constexpr (MODE == 2) {
                    if (bbf) {
                        const u32x4 bb = cb[bj];
                        v0[0] += __uint_as_float(bb.x << 16); v0[1] += __uint_as_float(bb.x & 0xffff0000u); v0[2] += __uint_as_float(bb.y << 16); v0[3] += __uint_as_float(bb.y & 0xffff0000u);
                        v1[0] += __uint_as_float(bb.z << 16); v1[1] += __uint_as_float(bb.z & 0xffff0000u); v1[2] += __uint_as_float(bb.w << 16); v1[3] += __uint_as_float(bb.w & 0xffff0000u);
                    } else { v0 += cf[bj][0]; v1 += cf[bj][1]; }
                    if (u.flag & 2) { float* op = (float*)u.out + roff + bj * HALF; *(f32x4*)op = v0; *(f32x4*)(op + 4) = v1; }
                    if (u.hb) {
                        u32x4 w; w.x = pack_bf16(v0[0], v0[1]); w.y = pack_bf16(v0[2], v0[3]); w.z = pack_bf16(v1[0], v1[1]); w.w = pack_bf16(v1[2], v1[3]);
                        *(u32x4*)(u.hb + roff + bj * HALF) = w;
#pragma unroll
                        for (int j = 0; j < 4; ++j) q += v0[j] * v0[j] + v1[j] * v1[j];
                    }
                } else {
                    if constexpr (MODE == 3) {
                        if (u.flag) { v0 *= cs[bj][0]; v1 *= cs[bj][1]; } else { v0 *= rr; v1 *= rr; }
                    }
                    u32x4 w; w.x = pack_bf16(v0[0], v0[1]); w.y = pack_bf16(v0[2], v0[3]); w.z = pack_bf16(v1[0], v1[1]); w.w = pack_bf16(v1[2], v1[3]);
                    *(u32x4*)((bf16_t*)u.out + roff + bj * HALF) = w;
                }
            }
            if constexpr (MODE == 2) {
                if (u.hb) { q += __shfl_xor(q, 16); q += __shfl_xor(q, 32); if (fq == 0) unsafeAtomicAdd(u.ss + row, q); }
            }
        }
}

constexpr int EPI_OFF = STAGE_BYTES + 256, EPI_ROW_B = 144, EPI_WAVE_B = 16 * EPI_ROW_B;
DI void epilogue_rows(const f32x4 (&acc)[2][2][4][2], const Unit& u, int wr, int wc, int fr, int fq, LAS unsigned char* patch, int lane, const float (&ssr)[8]) {
    const int row0 = u.row0 + wr * 64, col0 = u.col0 + wc * 64;
    float rrs[8];
#pragma unroll
    for (int it = 0; it < 8; ++it) { const float t = rs_of(ssr[it]); rrs[it] = t * t; }
#pragma unroll
    for (int ai = 0; ai < 2; ++ai)
#pragma unroll
        for (int m = 0; m < 4; ++m) {
            const int rbase = row0 + ai * HALF + m * 16;
            const float rr = rrs[ai * 4 + m];
#pragma unroll
            for (int bj = 0; bj < 2; ++bj) {
                f32x4 v0 = acc[ai][bj][m][0], v1 = acc[ai][bj][m][1];
#pragma unroll
                for (int j = 0; j < 4; ++j) { float a = fmaxf(v0[j], 0.f), b = fmaxf(v1[j], 0.f); v0[j] = a * a * rr; v1[j] = b * b * rr; }
                u32x4 w; w.x = pack_bf16(v0[0], v0[1]); w.y = pack_bf16(v0[2], v0[3]); w.z = pack_bf16(v1[0], v1[1]); w.w = pack_bf16(v1[2], v1[3]);
                *(LAS u32x4*)(patch + fr * EPI_ROW_B + (32 * bj + 8 * fq) * 2) = w;
            }
#pragma unroll
            for (int i = 0; i < 2; ++i) {
                const int pc = lane + 64 * i, row = pc >> 3, ch = pc & 7;
                const u32x4 w = *(const LAS u32x4*)(patch + row * EPI_ROW_B + ch * 16);
                __builtin_nontemporal_store(w, (u32x4*)((bf16_t*)u.out + (size_t)(rbase + row) * u.ldc + col0 + ch * 8));
            }
        }
}

template <int K, int MODE, int PH>
DI void gemm_phase(LAS unsigned char* lds, const Params& p) {
    int tid = threadIdx.x; asm volatile("" : "+v"(tid));
    const int wid = __builtin_amdgcn_readfirstlane(tid >> 6), lane = tid & 63, wr = wid >> 2, wc = wid & 3, fr = lane & 15, fq = lane >> 4;
    constexpr int nt = K / BK;
    constexpr bool REMAP = (MODE == 1);
    unsigned voffA[2], voffB0[2], voffB1[2];
#pragma unroll
    for (int i = 0; i < 2; ++i) { int R, C; stage_rc(tid * 16 + i * 8192, R, C);
        voffA[i] = (unsigned)(R * K + C) * 2u;
        if constexpr (REMAP) { const int Rb = 64 * (R >> 5) + perm32(R & 31); voffB0[i] = (unsigned)(Rb * K + C) * 2u; voffB1[i] = (unsigned)((Rb + 32) * K + C) * 2u; }
        else { const int Rb = (R & ~31) + perm32(R & 31); voffB0[i] = (unsigned)(Rb * K + C) * 2u; voffB1[i] = (unsigned)((Rb + HALF) * K + C) * 2u; } }
    constexpr size_t kstep = (size_t)(BK * 2);
    constexpr size_t hstep = (size_t)HALF * K * 2;
    const unsigned ldsw = (unsigned)wid * 1024u;
    const int aoff = lds_byte(wr * 64 + fr, fq * 8), boff = lds_byte(wc * 32 + fr, fq * 8);
#define PG8_SA(b, h) (((b) * 2 + (h)) * HTB)
#define PG8_SB(b, h) ((4 + (b) * 2 + (h)) * HTB)
#define PG8_STAGE(bufoff, gbase, voff) do { _Pragma("unroll") for (int _i = 0; _i < 2; ++_i) \
        __builtin_amdgcn_global_load_lds((const unsigned*)((const char*)(gbase) + (voff)[_i]), (LAS unsigned*)(lds + (bufoff) + ldsw + _i * 8192), 16, 0, 0); } while (0)
#define PG8_LDA(dst, b, h) do { _Pragma("unroll") for (int m = 0; m < 4; ++m) _Pragma("unroll") for (int k = 0; k < 2; ++k) dst[m][k] = *(const LAS bf16x8*)(lds + PG8_SA(b, h) + aoff + m * 2048 + k * 1024); } while (0)
#define PG8_LDB(dst, b, h) do { _Pragma("unroll") for (int n = 0; n < 2; ++n) _Pragma("unroll") for (int k = 0; k < 2; ++k) dst[n][k] = *(const LAS bf16x8*)(lds + PG8_SB(b, h) + boff + n * 2048 + k * 1024); } while (0)
#define PG8_MMA(ai, bj, At, Bt) do { __builtin_amdgcn_s_setprio(1); _Pragma("unroll") for (int m = 0; m < 4; ++m) _Pragma("unroll") for (int n = 0; n < 2; ++n) _Pragma("unroll") for (int k = 0; k < 2; ++k) \
        acc[ai][bj][m][n] = __builtin_amdgcn_mfma_f32_16x16x32_bf16(Bt[n][k], At[m][k], acc[ai][bj][m][n], 0, 0, 0); __builtin_amdgcn_s_setprio(0); } while (0)
#define PG8_WAIT_V(n) asm volatile("s_waitcnt vmcnt(" #n ")" ::: "memory")
#define PG8_WAIT_L(n) asm volatile("s_waitcnt lgkmcnt(" #n ")" ::: "memory")
#define PG8_BAR __builtin_amdgcn_s_barrier()
#define PG8_SCHED __builtin_amdgcn_sched_barrier(0)
    Unit cur, nxt; int ui = 0;
    if (!sched_next<PH>(p, 0, cur)) return;
    f32x4 acc[2][2][4][2];
#pragma unroll
    for (int a = 0; a < 2; ++a)
#pragma unroll
        for (int b = 0; b < 2; ++b)
#pragma unroll
            for (int m = 0; m < 4; ++m)
#pragma unroll
                for (int n = 0; n < 2; ++n) acc[a][b][m][n] = (f32x4){0.f, 0.f, 0.f, 0.f};
    bf16x8 At[4][2], B0[2][2], B1[2][2];
    const char* cA = cur.A; const char* cB = cur.B;
    PG8_STAGE(PG8_SB(0, 0), cB, voffB0); PG8_STAGE(PG8_SA(0, 0), cA, voffA); PG8_STAGE(PG8_SB(0, 1), cB, voffB1); PG8_STAGE(PG8_SA(0, 1), cA + hstep, voffA);
    if (wr == 1) PG8_BAR;
    PG8_WAIT_V(4); PG8_BAR;
    PG8_STAGE(PG8_SB(1, 0), cB + kstep, voffB0); PG8_STAGE(PG8_SA(1, 0), cA + kstep, voffA); PG8_STAGE(PG8_SB(1, 1), cB + kstep, voffB1);
    PG8_WAIT_V(6); PG8_BAR;
    for (;;) {
        const bool has_next = sched_next<PH>(p, ui + 1, nxt);
        float ssr[8];
        if constexpr (MODE == 1 || MODE == 3) {
            if (MODE == 1 || !cur.flag) {
#pragma unroll
                for (int it = 0; it < 8; ++it) ssr[it] = cur.ss[cur.row0 + wr * 64 + (it >> 2) * HALF + (it & 3) * 16 + fr];
            } else {
#pragma unroll
                for (int it = 0; it < 8; ++it) ssr[it] = 0.f;
            }
        } else {
#pragma unroll
            for (int it = 0; it < 8; ++it) ssr[it] = 0.f;
        }
        const char* nA = has_next ? nxt.A : cA; const char* nB = has_next ? nxt.B : cB;
        for (int t = 0; t < nt; t += 2) {
            const bool last = (t == nt - 2);
            const char* a1 = cA + (size_t)(t + 1) * kstep;
            const char* a2 = last ? nA : cA + (size_t)(t + 2) * kstep; const char* b2 = last ? nB : cB + (size_t)(t + 2) * kstep;
            const char* a3 = a2 + kstep; const char* b3 = b2 + kstep;
            PG8_LDB(B0, 0, 0); PG8_SCHED; PG8_LDA(At, 0, 0); PG8_STAGE(PG8_SA(1, 1), a1 + hstep, voffA);
            PG8_WAIT_L(8); PG8_BAR; PG8_WAIT_L(0); PG8_MMA(0, 0, At, B0); PG8_BAR; PG8_SCHED;
            PG8_LDB(B1, 0, 1); PG8_STAGE(PG8_SB(0, 0), b2, voffB0);
            PG8_BAR; PG8_WAIT_L(0); PG8_MMA(0, 1, At, B1); PG8_BAR;
            PG8_LDA(At, 0, 1); PG8_STAGE(PG8_SA(0, 0), a2, voffA);
            PG8_BAR; PG8_WAIT_L(0); PG8_MMA(1, 0, At, B0); PG8_BAR; PG8_SCHED;
            PG8_STAGE(PG8_SB(0, 1), b2, voffB1);
            PG8_WAIT_V(6); PG8_BAR; PG8_MMA(1, 1, At, B1); PG8_BAR;
            PG8_LDB(B0, 1, 0); PG8_SCHED; PG8_LDA(At, 1, 0); PG8_STAGE(PG8_SA(0, 1), a2 + hstep, voffA);
            PG8_WAIT_L(8); PG8_BAR; PG8_WAIT_L(0); PG8_MMA(0, 0, At, B0); PG8_BAR; PG8_SCHED;
            PG8_LDB(B1, 1, 1); PG8_STAGE(PG8_SB(1, 0), b3, voffB0);
            PG8_BAR; PG8_WAIT_L(0); PG8_MMA(0, 1, At, B1); PG8_BAR;
            PG8_LDA(At, 1, 1); PG8_STAGE(PG8_SA(1, 0), a3, voffA);
            PG8_BAR; PG8_WAIT_L(0); PG8_MMA(1, 0, At, B0); PG8_BAR; PG8_SCHED;
            PG8_STAGE(PG8_SB(1, 1), b3, voffB1);
            PG8_WAIT_V(6); PG8_BAR; PG8_MMA(1, 1, At, B1); PG8_BAR;
        }
        if constexpr (REMAP) epilogue_rows(acc, cur, wr, wc, fr, fq, lds + EPI_OFF + wid * EPI_WAVE_B, lane, ssr); else epilogue<MODE>(acc, cur, wr, wc, fr, fq, ssr);
        if (!has_next) break;
#pragma unroll
        for (int a = 0; a < 2; ++a)
#pragma unroll
            for (int b = 0; b < 2; ++b)
#pragma unroll
                for (int m = 0; m < 4; ++m)
#pragma unroll
                    for (int n = 0; n < 2; ++n) acc[a][b][m][n] = (f32x4){0.f, 0.f, 0.f, 0.f};
        cur = nxt; cA = nA; cB = nB; ++ui;
    }
    PG8_WAIT_V(0);
    if (wr == 0) PG8_BAR;
    PG8_BAR;
#undef PG8_SA
#undef PG8_SB
#undef PG8_STAGE
#undef PG8_LDA
#undef PG8_LDB
#undef PG8_MMA
#undef PG8_WAIT_V
#undef PG8_WAIT_L
#undef PG8_BAR
#undef PG8_SCHED
}

struct CvtDesc { const float* s; bf16_t* dt; const float* g; int ld, K; };
DI CvtDesc cvt_lookup(const Params& p, int t) {
    const float* src; int ld, K = 2048, nct; bf16_t* dst; const float* gain;
    bf16_t* WA = (bf16_t*)(p.ws + OFF_WT_INA); bf16_t* WB = (bf16_t*)(p.ws + OFF_WT_B1);
    if (t < 384) { src = p.w_in_a; ld = 5120; nct = 24; dst = WA; gain = p.norm_attn; }
    else if ((t -= 384) < 64) { src = p.w_in_a + 4608; ld = 5120; nct = 4; dst = WA + (size_t)3072 * 2048; gain = p.norm_attn; }
    else if ((t -= 64) < 192) { src = p.w_in_a + 3072; ld = 5120; nct = 12; dst = WA + (size_t)3584 * 2048; gain = p.norm_attn; }
    else if ((t -= 192) < 256) { src = p.w_q_b; ld = 2048; nct = 16; dst = WB; gain = p.norm_attn + 2048; }
    else if ((t -= 256) < 384) { src = p.w_kv_shared; ld = 3072; nct = 24; dst = WB + (size_t)2048 * 2048; gain = p.norm_kv; }
    else if ((t -= 384) < 256) { const int l = t >> 7; t &= 127; src = p.w_mem_kv + (size_t)l * 2048 * 1024; ld = 1024; nct = 8;
        dst = (bf16_t*)(p.ws + OFF_WT_MEMKV) + (size_t)l * 1024 * 2048; gain = p.norm_mem + l * 2048; }
    else if ((t -= 256) < 512) { const int l = t >> 8; t &= 255; src = p.w_o + (size_t)l * 2048 * 2048; ld = 2048; nct = 16;
        dst = (bf16_t*)(p.ws + OFF_WT_O) + (size_t)l * 2048 * 2048; gain = nullptr; }
    else if ((t -= 512) < 2048) { const int l = t >> 10; t &= 1023; src = p.w_mlp_in + (size_t)l * 2048 * 8192; ld = 8192; nct = 64;
        dst = (bf16_t*)(p.ws + OFF_WT_MLPIN) + (size_t)l * 8192 * 2048; gain = p.norm_mlp + l * 2048; }
    else { t -= 2048; const int l = t >> 10; t &= 1023; src = p.w_mlp_out + (size_t)l * 8192 * 2048; ld = 2048; K = 8192; nct = 16;
        dst = (bf16_t*)(p.ws + OFF_WT_MLPOUT) + (size_t)l * 2048 * 8192; gain = nullptr; }
    int tid = threadIdx.x; asm volatile("" : "+v"(tid));
    const int w = tid >> 6, lane = tid & 63;
    const int kt0 = (t / nct) * 128, nt0 = (t % nct) * 128, k0 = kt0 + w * 16;
    CvtDesc d; d.s = src + (size_t)k0 * ld + nt0 + lane * 2; d.dt = dst + (size_t)nt0 * K + kt0; d.g = gain ? gain + k0 : nullptr; d.ld = ld; d.K = K;
    return d;
}
struct CvtRegs { float a[16], b[16], g[16]; };
DI void cvt_load(const CvtDesc& d, CvtRegs& r) {
#pragma unroll
    for (int kk = 0; kk < 16; ++kk) { const f32x2 v = __builtin_nontemporal_load((const f32x2*)(d.s + (size_t)kk * d.ld)); r.a[kk] = v.x; r.b[kk] = v.y; }
    if (d.g) {
#pragma unroll
        for (int kk = 0; kk < 16; ++kk) r.g[kk] = d.g[kk];
    } else {
#pragma unroll
        for (int kk = 0; kk < 16; ++kk) r.g[kk] = 1.0f;
    }
}
constexpr int CROW_B = 272;
DI void cvt_to_lds(LAS unsigned char* lds, int w, int lane, CvtRegs& r) {
#pragma unroll
    for (int kk = 0; kk < 16; ++kk) { r.a[kk] *= r.g[kk]; r.b[kk] *= r.g[kk]; }
    LAS unsigned char* r0 = lds + (2 * lane) * CROW_B + w * 32;
    *(LAS bf16x8*)r0 = pack8(r.a); *(LAS bf16x8*)(r0 + 16) = pack8(r.a + 8);
    *(LAS bf16x8*)(r0 + CROW_B) = pack8(r.b); *(LAS bf16x8*)(r0 + CROW_B + 16) = pack8(r.b + 8);
}
DI void cvt_store_pass(LAS unsigned char* lds, int tid, bf16_t* dt, int K) {
#pragma unroll
    for (int i = 0; i < 4; ++i) {
        const int pc = tid + 512 * i, row = pc >> 4, ch = pc & 15;
        const bf16x8 v = *(const LAS bf16x8*)(lds + row * CROW_B + ch * 16);
        *(bf16x8*)(dt + (size_t)row * K + ch * 8) = v;
    }
}
DI void convert_seq(LAS unsigned char* lds, const Params& p, int first, int limit, int stride) {
    if (first >= limit) return;
    int tid = threadIdx.x; asm volatile("" : "+v"(tid));
    const int w = tid >> 6, lane = tid & 63;
    CvtRegs rA, rB;
    CvtDesc dA = cvt_lookup(p, first), dB = dA;
    cvt_load(dA, rA);
    if (first + stride < limit) { dB = cvt_lookup(p, first + stride); cvt_load(dB, rB); }
    for (int t = first; t < limit; t += 2 * stride) {
        {
            cvt_to_lds(lds, w, lane, rA);
            bf16_t* dt = dA.dt; const int K = dA.K;
            __syncthreads();
            if (t + 2 * stride < limit) { dA = cvt_lookup(p, t + 2 * stride); cvt_load(dA, rA); }
            cvt_store_pass(lds, tid, dt, K);
            __syncthreads();
        }
        if (t + stride < limit) {
            cvt_to_lds(lds, w, lane, rB);
            bf16_t* dt = dB.dt; const int K = dB.K;
            __syncthreads();
            if (t + 3 * stride < limit) { dB = cvt_lookup(p, t + 3 * stride); cvt_load(dB, rB); }
            cvt_store_pass(lds, tid, dt, K);
            __syncthreads();
        }
    }
}
DI void rowscale(const float* src, bf16_t* dst, int nrows) {
    int tid = threadIdx.x; asm volatile("" : "+v"(tid));
    const int w = tid >> 6, lane = tid & 63;
    for (int row = blockIdx.x * 8 + w; row < nrows; row += gridDim.x * 8) {
        const float* s = src + (size_t)row * 2048;
        f32x4 v[8]; float ss = 0.f;
#pragma unroll
        for (int j = 0; j < 4; ++j) { v[2 * j] = __builtin_nontemporal_load((const f32x4*)(s + (j * 64 + lane) * 8)); v[2 * j + 1] = __builtin_nontemporal_load((const f32x4*)(s + (j * 64 + lane) * 8 + 4)); }
#pragma unroll
        for (int j = 0; j < 8; ++j) ss += v[j][0] * v[j][0] + v[j][1] * v[j][1] + v[j][2] * v[j][2] + v[j][3] * v[j][3];
#pragma unroll
        for (int o = 32; o >= 1; o >>= 1) ss += __shfl_xor(ss, o);
        const float r = rsqrtf(ss * (1.0f / 2048.0f) + EPS);
#pragma unroll
        for (int j = 0; j < 4; ++j) {
            u32x4 o; o.x = pack_bf16(v[2 * j][0] * r, v[2 * j][1] * r); o.y = pack_bf16(v[2 * j][2] * r, v[2 * j][3] * r);
            o.z = pack_bf16(v[2 * j + 1][0] * r, v[2 * j + 1][1] * r); o.w = pack_bf16(v[2 * j + 1][2] * r, v[2 * j + 1][3] * r);
            *(u32x4*)(dst + (size_t)row * 2048 + (j * 64 + lane) * 8) = o;
        }
    }
}

constexpr int KROW_B = 272, VROW_B = 144, KBUF_B = 64 * KROW_B, VBUF_B = 128 * VROW_B, ABUF_B = KBUF_B + VBUF_B, BIAS_OFF = 2 * ABUF_B, OROW_B = 272;
#define MFMA32(a, b, c) __builtin_amdgcn_mfma_f32_32x32x16_bf16((a), (b), (c), 0, 0, 0)

DI void sb_block(const f32x16& st, bool diag, int r, int hh, float& R, float* pv) {
    float sp[16];
    float totA = 0.f, totB = 0.f;
#pragma unroll
    for (int i = 0; i < 16; ++i) {
        const float t = st[i] * (ATT_SCALE * LOG2E);
        const float e = __builtin_amdgcn_exp2f(-fabsf(t));
        float v = fmaxf(t, 0.f) + __builtin_amdgcn_logf(1.0f + e);
        if (diag && !((16 * (i >> 3) + 8 * hh + (i & 7)) < r)) v = 0.f;
        sp[i] = v;
        if (i < 8) totA += v; else totB += v;
    }
    const float oA = __shfl_xor(totA, 32), oB = __shfl_xor(totB, 32);
    float accA = R + (hh == 0 ? (oA + totB + oB) : (oB + totB)), accB = R + (hh == 0 ? oB : 0.f);
#pragma unroll
    for (int i = 7; i >= 0; --i) {
        const float tA = st[i] * (ATT_SCALE * LOG2E), tB = st[8 + i] * (ATT_SCALE * LOG2E);
        float a = __builtin_amdgcn_exp2f(tA - sp[i] - accA), b = __builtin_amdgcn_exp2f(tB - sp[8 + i] - accB);
        accA += sp[i]; accB += sp[8 + i];
        if (diag && !((8 * hh + i) < r)) a = 0.f;
        if (diag && !((16 + 8 * hh + i) < r)) b = 0.f;
        pv[i] = a; pv[8 + i] = b;
    }
    R += (totA + totB) + (oA + oB);
}

template <int MODE>
DI void attn_item(LAS unsigned char* lds, const bf16_t* Qp, int ldq, const bf16_t* Kp, int ldk, const bf16_t* VTp, int ldv, bf16_t* Yp, int q0,
                  const float* gq, const float* gk, const float* biasT_h) {
    int tid = threadIdx.x; asm volatile("" : "+v"(tid));
    const int w = __builtin_amdgcn_readfirstlane(tid >> 6), lane = tid & 63, r = lane & 31, hh = lane >> 5;
    const int rp = (r & ~12) | ((r & 4) << 1) | ((r & 8) >> 1);
    int s_hi, s_lo;
    if constexpr (MODE == 0) { const int n0 = q0 >> 6; s_hi = n0 + 3; s_lo = n0 - 8 > 0 ? n0 - 8 : 0; }
    else if constexpr (MODE == 1) { s_hi = 3; s_lo = 0; }
    else { s_hi = (q0 >> 6) + 3; s_lo = 0; }

    bf16x8 qf[8];
    {
        const bf16_t* qrow = Qp + (size_t)(q0 + w * 32 + r) * ldq + hh * 8;
#pragma unroll
        for (int kk = 0; kk < 8; ++kk) qf[kk] = *(const bf16x8*)(qrow + kk * 16);
        if constexpr (MODE != 2) {
            float ss = 0.f;
#pragma unroll
            for (int kk = 0; kk < 8; ++kk)
#pragma unroll
                for (int j = 0; j < 8; ++j) { const float f = bf2f(qf[kk][j]); ss += f * f; }
            ss += __shfl_xor(ss, 32);
            const float rq = rsqrtf(ss * (1.0f / 128.0f) + EPS) * (ATT_SCALE * LOG2E);
#pragma unroll
            for (int kk = 0; kk < 8; ++kk) {
                const f32x4 g0 = *(const f32x4*)(gq + kk * 16 + hh * 8), g1 = *(const f32x4*)(gq + kk * 16 + hh * 8 + 4);
                float f[8];
#pragma unroll
                for (int j = 0; j < 4; ++j) { f[j] = bf2f(qf[kk][j]) * rq * g0[j]; f[4 + j] = bf2f(qf[kk][4 + j]) * rq * g1[j]; }
                qf[kk] = pack8(f);
            }
        }
    }
    const int krow = tid >> 4, kc16 = tid & 15, vrow = tid >> 3, vc16 = tid & 7;
    f32x4 gk0 = {1.f, 1.f, 1.f, 1.f}, gk1 = gk0;
    if constexpr (MODE != 2) { gk0 = *(const f32x4*)(gk + kc16 * 8); gk1 = *(const f32x4*)(gk + kc16 * 8 + 4); }
    const bf16_t* kg = Kp + (size_t)krow * ldk + kc16 * 8;
    const bf16_t* vg = VTp + (size_t)vrow * ldv + vc16 * 8;
    const unsigned kst = krow * KROW_B + kc16 * 16, vst = KBUF_B + vrow * VROW_B + vc16 * 16;
    if constexpr (MODE == 0) { LAS float* bl = (LAS float*)(lds + BIAS_OFF); for (int i = tid; i < 640; i += 512) bl[i] = biasT_h[i]; }
    LAS int* sbflag = (LAS int*)(lds + BIAS_OFF);
    if constexpr (MODE == 2) { if (tid < 16) sbflag[tid] = 0; }
    bool wave_done = false;

    f32x16 o[4];
#pragma unroll
    for (int d = 0; d < 4; ++d)
#pragma unroll
        for (int i = 0; i < 16; ++i) o[d][i] = 0.f;
    float m_run = -1e30f, l_run = 0.f, R = 0.f;

    bf16x8 kreg[2], vreg[2];
#pragma unroll
    for (int i = 0; i < 2; ++i) { kreg[i] = *(const bf16x8*)(kg + (size_t)(s_hi * 64 + i * 32) * ldk); vreg[i] = *(const bf16x8*)(vg + (size_t)(i * 64) * ldv + s_hi * 64); }
    for (int s = s_hi; s >= s_lo; --s) {
        const int buf = (s_hi - s) & 1;
        LAS unsigned char* B = lds + buf * ABUF_B;
#pragma unroll
        for (int i = 0; i < 2; ++i) {
            if constexpr (MODE != 2) {
                float f[8]; float ss = 0.f;
#pragma unroll
                for (int j = 0; j < 8; ++j) { f[j] = bf2f(kreg[i][j]); ss += f[j] * f[j]; }
                ss = dpp_sum16(ss);
                const float rk = rsqrtf(ss * (1.0f / 128.0f) + EPS);
#pragma unroll
                for (int j = 0; j < 4; ++j) { f[j] *= rk * gk0[j]; f[4 + j] *= rk * gk1[j]; }
                kreg[i] = pack8(f);
            }
            *(LAS bf16x8*)(B + kst + i * 32 * KROW_B) = kreg[i]; *(LAS bf16x8*)(B + vst + i * 64 * VROW_B) = vreg[i];
        }
        __syncthreads();
        if constexpr (MODE == 2) {
            int alldone = 1;
#pragma unroll
            for (int i = 0; i < 8; ++i) alldone &= sbflag[buf * 8 + i];
            if (alldone) break;
        }
        if (s > s_lo) {
#pragma unroll
            for (int i = 0; i < 2; ++i) { kreg[i] = *(const bf16x8*)(kg + (size_t)((s - 1) * 64 + i * 32) * ldk); vreg[i] = *(const bf16x8*)(vg + (size_t)(i * 64) * ldv + (s - 1) * 64); }
        }
        bool active;
        if constexpr (MODE == 0) { const int c = (q0 >> 6) + (w >> 1); active = (s >= c - 8) && (s <= c); }
        else if constexpr (MODE == 1) active = true;
        else active = (s <= (q0 >> 6) + (w >> 1)) && !wave_done;
        if (active) {
            float pv[32];
            bool both = true;
            if constexpr (MODE == 2) both = (2 * s + 1) <= (q0 >> 5) + w;
            const LAS unsigned char* Kb = B + rp * KROW_B + hh * 16;
            const LAS unsigned char* Vb = B + KBUF_B + r * VROW_B + hh * 16;
            f32x16 st0, st1;
#pragma unroll
            for (int i = 0; i < 16; ++i) { st0[i] = 0.f; st1[i] = 0.f; }
            if (both) {
                bf16x8 fa[8], fb[8];
#pragma unroll
                for (int kk = 0; kk < 8; ++kk) fa[kk] = *(const LAS bf16x8*)(Kb + kk * 32);
                __builtin_amdgcn_sched_barrier(0);
#pragma unroll
                for (int kk = 0; kk < 8; ++kk) fb[kk] = *(const LAS bf16x8*)(Kb + 32 * KROW_B + kk * 32);
#pragma unroll
                for (int kk = 0; kk < 8; ++kk) st0 = MFMA32(fa[kk], qf[kk], st0);
                __builtin_amdgcn_sched_barrier(0);
                constexpr int JA = (MODE == 2) ? 1 : 0, JB = 1 - JA;
#pragma unroll
                for (int d = 0; d < 4; ++d)
#pragma unroll
                    for (int ks = 0; ks < 2; ++ks) fa[d * 2 + ks] = *(const LAS bf16x8*)(Vb + d * 32 * VROW_B + JA * 64 + ks * 32);
#pragma unroll
                for (int kk = 0; kk < 8; ++kk) st1 = MFMA32(fb[kk], qf[kk], st1);
                __builtin_amdgcn_sched_barrier(0);
#define LOAD_FB() do { _Pragma("unroll") for (int d = 0; d < 4; ++d) _Pragma("unroll") for (int ks = 0; ks < 2; ++ks) \
                    fb[d * 2 + ks] = *(const LAS bf16x8*)(Vb + d * 32 * VROW_B + JB * 64 + ks * 32); } while (0)
                if constexpr (MODE != 2) {
                    float sc[32];
                    if constexpr (MODE == 0) {
                        const LAS float* bl = (const LAS float*)(lds + BIAS_OFF) + ((q0 + w * 32 + r) - s * 64 - 8 * hh + 63);
#pragma unroll
                        for (int i = 0; i < 16; ++i) { sc[i] = st0[i] + bl[-(16 * (i >> 3) + (i & 7))]; sc[16 + i] = st1[i] + bl[-(32 + 16 * (i >> 3) + (i & 7))]; }
                    } else {
#pragma unroll
                        for (int i = 0; i < 16; ++i) { sc[i] = st0[i]; sc[16 + i] = st1[i]; }
                    }
                    float mx = sc[0];
#pragma unroll
                    for (int i = 1; i < 32; ++i) mx = fmaxf(mx, sc[i]);
                    mx = fmaxf(mx, __shfl_xor(mx, 32));
                    const float mnew = fmaxf(m_run, mx);
                    if (__any(mnew > m_run)) {
                        const float alpha = __builtin_amdgcn_exp2f(m_run - mnew);
                        l_run *= alpha;
#pragma unroll
                        for (int d = 0; d < 4; ++d)
#pragma unroll
                            for (int i = 0; i < 16; ++i) o[d][i] *= alpha;
                        m_run = mnew;
                    }
                    float ps = 0.f;
#pragma unroll
                    for (int i = 0; i < 32; ++i) { pv[i] = __builtin_amdgcn_exp2f(sc[i] - m_run); ps += pv[i]; }
                    l_run += ps;
                    const bf16x8 pf0 = pack8(pv), pf1 = pack8(pv + 8), pf2 = pack8(pv + 16), pf3 = pack8(pv + 24);
                    __builtin_amdgcn_sched_barrier(0);
                    LOAD_FB();
#pragma unroll
                    for (int d = 0; d < 4; ++d) { o[d] = MFMA32(fa[d * 2], pf0, o[d]); o[d] = MFMA32(fa[d * 2 + 1], pf1, o[d]); }
                    __builtin_amdgcn_sched_barrier(0);
#pragma unroll
                    for (int d = 0; d < 4; ++d) { o[d] = MFMA32(fb[d * 2], pf2, o[d]); o[d] = MFMA32(fb[d * 2 + 1], pf3, o[d]); }
                } else {
                    const int kdiag = (q0 >> 5) + w;
                    sb_block(st1, (2 * s + 1) == kdiag, r, hh, R, pv + 16);
                    const bf16x8 pf2 = pack8(pv + 16), pf3 = pack8(pv + 24);
#pragma unroll
                    for (int d = 0; d < 4; ++d) { o[d] = MFMA32(fa[d * 2], pf2, o[d]); o[d] = MFMA32(fa[d * 2 + 1], pf3, o[d]); }
                    __builtin_amdgcn_sched_barrier(0);
                    sb_block(st0, false, r, hh, R, pv);
                    const bf16x8 pf0 = pack8(pv), pf1 = pack8(pv + 8);
                    __builtin_amdgcn_sched_barrier(0);
                    LOAD_FB();
#pragma unroll
                    for (int d = 0; d < 4; ++d) { o[d] = MFMA32(fb[d * 2], pf0, o[d]); o[d] = MFMA32(fb[d * 2 + 1], pf1, o[d]); }
                }
#undef LOAD_FB
            } else {
                if constexpr (MODE == 2) {
#pragma unroll
                    for (int kk = 0; kk < 8; ++kk) { const bf16x8 kf = *(const LAS bf16x8*)(Kb + kk * 32); st0 = MFMA32(kf, qf[kk], st0); }
                    sb_block(st0, true, r, hh, R, pv);
                    const bf16x8 pf0 = pack8(pv), pf1 = pack8(pv + 8);
#pragma unroll
                    for (int d = 0; d < 4; ++d) {
                        const bf16x8 v0 = *(const LAS bf16x8*)(Vb + d * 32 * VROW_B), v1 = *(const LAS bf16x8*)(Vb + d * 32 * VROW_B + 32);
                        o[d] = MFMA32(v0, pf0, o[d]); o[d] = MFMA32(v1, pf1, o[d]);
                    }
                }
            }
            if constexpr (MODE == 2) { if (__all(R >= SB_DONE)) wave_done = true; }
        }
        if constexpr (MODE == 2) { if (lane == 0) sbflag[(buf ^ 1) * 8 + w] = wave_done ? 1 : 0; }
    }
    float inv = 1.f;
    if constexpr (MODE != 2) { const float lt = l_run + __shfl_xor(l_run, 32); inv = 1.0f / lt; }
    __syncthreads();
    LAS unsigned char* ob = lds + w * (32 * OROW_B);
#pragma unroll
    for (int d = 0; d < 4; ++d)
#pragma unroll
        for (int g = 0; g < 4; ++g) {
            u32x2 v; v.x = pack_bf16(o[d][4 * g] * inv, o[d][4 * g + 1] * inv); v.y = pack_bf16(o[d][4 * g + 2] * inv, o[d][4 * g + 3] * inv);
            *(LAS u32x2*)(ob + r * OROW_B + (d * 32 + 8 * g + 4 * hh) * 2) = v;
        }
    __syncthreads();
#pragma unroll
    for (int i = 0; i < 8; ++i) {
        const int pc = lane + 64 * i, row = pc >> 4, ch = pc & 15;
        const bf16x8 v = *(const LAS bf16x8*)(ob + row * OROW_B + ch * 16);
        *(bf16x8*)(Yp + (size_t)(q0 + w * 32 + row) * 2048 + ch * 8) = v;
    }
    __syncthreads();
}

DI void mem_item(LAS unsigned char* lds, const Params& p, int l, int j, int qcol0) {
    const int bm = j >> 3, I = j & 7, b = bm >> 2, m = bm & 3;
    const bf16_t* QK = (const bf16_t*)(p.ws + OFF_QK);
    attn_item<1>(lds, QK + (size_t)b * 2048 * 3584 + qcol0 + m * 128, 3584,
                 (const bf16_t*)(p.ws + OFF_KM) + (size_t)l * 2048 * 512 + (size_t)b * 256 * 512 + m * 128, 512,
                 (const bf16_t*)(p.ws + OFF_VMT) + (size_t)l * 512 * 2048 + (size_t)m * 128 * 2048 + b * 256, 2048,
                 (bf16_t*)(p.ws + OFF_YCAT) + (size_t)b * 2048 * 2048 + 1536 + m * 128, I * 256,
                 p.qk_gain_mem + l * 256, p.qk_gain_mem + l * 256 + 128, nullptr);
}


#define XB_TMO      128
#define XB_XCNT(j)  (256  + 64 * (j))
#define XB_XSUB(j)  (1280 + 64 * (j))
#define XB_XGEN(j)  (2304 + 64 * (j))
#define XB_TOP      3328
#define XB_TOPGEN   3392
#define XCD_BAR_WORDS 3456
#define XB_SPIN_CAP (1u << 22)
DI unsigned xb_ld(unsigned* p) { return __hip_atomic_load(p, __ATOMIC_RELAXED, __HIP_MEMORY_SCOPE_AGENT); }
DI unsigned xb_add(unsigned* p, unsigned v) { return __hip_atomic_fetch_add(p, v, __ATOMIC_RELAXED, __HIP_MEMORY_SCOPE_AGENT); }
DI unsigned xb_xcc_id() { return (unsigned)__builtin_amdgcn_s_getreg((3 << 11) | 20) & 0xFu; }
#define XB_SPIN(cond, bar) do { unsigned _sp = 0; while (cond) { __builtin_amdgcn_s_sleep(1); \
    if ((++_sp & 255u) == 0u) { if (xb_ld(&(bar)[XB_TMO])) break; if (_sp > XB_SPIN_CAP) { atomicAdd(&(bar)[XB_TMO], 1u); break; } } } } while (0)
struct XcdBarrier { unsigned* bar; unsigned x; volatile LAS unsigned* st; };
DI XcdBarrier xcd_barrier_post(unsigned* bar, volatile LAS unsigned* st) {
    XcdBarrier b; b.bar = bar; b.x = xb_xcc_id(); b.st = st;
    if (threadIdx.x == 0) (void)xb_add(&bar[XB_XCNT(b.x)], 1u);
    return b;
}
DI void xcd_barrier_complete(unsigned* bar, unsigned x, unsigned& nloc, unsigned& nx) {
    const unsigned G = gridDim.x * gridDim.y * gridDim.z;
    unsigned sum, cnt, mine, sp = 0u;
    for (;;) {
        sum = 0u; cnt = 0u; mine = 0u;
#pragma unroll
        for (unsigned j = 0; j < 16; ++j) { const unsigned c = xb_ld(&bar[XB_XCNT(j)]); sum += c; cnt += (c > 0u) ? 1u : 0u; mine = (j == x) ? c : mine; }
        if (sum == G) break;
        __builtin_amdgcn_s_sleep(1);
        if ((++sp & 255u) == 0u) { if (xb_ld(&bar[XB_TMO])) break; if (sp > XB_SPIN_CAP) { atomicAdd(&bar[XB_TMO], 1u); break; } }
    }
    nloc = mine > 0u ? mine : 1u; nx = cnt > 0u ? cnt : 1u;
}
DI void xcd_barrier(const XcdBarrier& b) {
    asm volatile("s_waitcnt vmcnt(0)" ::: "memory");
    __syncthreads();
    if (threadIdx.x == 0) {
        unsigned* bar = b.bar;
        __builtin_amdgcn_s_waitcnt(0);
        unsigned nloc = b.st[0], nx = b.st[1];
        if (nloc == 0u) { xcd_barrier_complete(bar, b.x, nloc, nx); b.st[0] = nloc; b.st[1] = nx; }
        const unsigned old = xb_add(&bar[XB_XSUB(b.x)], 1u);
        const unsigned gen = old / nloc;
        if (old + 1u == (gen + 1u) * nloc) {
            __builtin_amdgcn_fence(__ATOMIC_RELEASE, "agent");
            asm volatile("s_waitcnt vmcnt(0)" ::: "memory");
            const unsigned og = xb_add(&bar[XB_TOP], 1u);
            const unsigned tg = og / nx;
            if (og + 1u == (tg + 1u) * nx) xb_add(&bar[XB_TOPGEN], 1u);
            else XB_SPIN(xb_ld(&bar[XB_TOPGEN]) == tg, bar);
            __builtin_amdgcn_fence(__ATOMIC_ACQUIRE, "agent");
            xb_add(&bar[XB_XGEN(b.x)], 1u);
            asm volatile("s_waitcnt vmcnt(0)" ::: "memory");
        } else {
            XB_SPIN(xb_ld(&bar[XB_XGEN(b.x)]) == gen, bar);
            __builtin_amdgcn_fence(__ATOMIC_ACQUIRE, "agent");
            asm volatile("s_waitcnt vmcnt(0)" ::: "memory");
        }
    }
    __syncthreads();
}

constexpr int LDS_BYTES = STAGE_BYTES + 256 + 8 * EPI_WAVE_B;

__global__ void __launch_bounds__(512, 2) mega(Params p) {
    extern __shared__ __attribute__((aligned(16))) unsigned char shm_raw[];
    LAS unsigned char* lds = (LAS unsigned char*)shm_raw;
    cg::grid_group grid = cg::this_grid();
    const int tid = threadIdx.x;
    bf16_t* RA = (bf16_t*)(p.ws + OFF_RA);
    unsigned* ctr = (unsigned*)(p.ws + OFF_CTR);
    volatile LAS unsigned* xst = (volatile LAS unsigned*)(lds + STAGE_BYTES);
    if (tid == 0) { xst[0] = 0u; xst[1] = 0u; }
    __syncthreads();
    const XcdBarrier xb = xcd_barrier_post((unsigned*)(p.ws + OFF_BAR), xst);

    convert_seq(lds, p, (int)blockIdx.x, 4096, (int)gridDim.x);
    rowscale(p.x, RA, 16384);
    rowscale(p.mem, (bf16_t*)(p.ws + OFF_MEMN), 2048);
    {
        float* bt = (float*)(p.ws + OFF_BIAST);
        for (int i = blockIdx.x * 512 + tid; i < 12 * 640; i += gridDim.x * 512) {
            const int h = i / 640, idx = i % 640; int dist = idx - 63; if (dist > 256) dist = 256;
            bt[i] = p.rel_bias[(dist + 256) * 12 + h] * LOG2E;
        }
    }
    if (p.ws == nullptr) grid.sync();
    xcd_barrier(xb);
    gemm_phase<2048, 0, 1>(lds, p);
    {
        const int nfree = (int)gridDim.x - 64;
        if (nfree > 0) { if ((int)blockIdx.x >= 64) convert_seq(lds, p, 4096 + (int)blockIdx.x - 64, 6144, nfree); }
        else convert_seq(lds, p, 4096 + (int)blockIdx.x, 6144, (int)gridDim.x);
    }
    xcd_barrier(xb);
    for (int it = blockIdx.x; it < 1024; it += gridDim.x) {
        if (it < 768) {
            const int bh = it >> 3, I = it & 7, b = bh / 12, h = bh % 12;
            const bf16_t* QK = (const bf16_t*)(p.ws + OFF_QK) + (size_t)b * 2048 * 3584;
            attn_item<0>(lds, QK + h * 128, 3584, QK + 1536 + h * 128, 3584,
                         (const bf16_t*)(p.ws + OFF_VT) + (size_t)h * 128 * 16384 + b * 2048, 16384,
                         (bf16_t*)(p.ws + OFF_YCAT) + (size_t)b * 2048 * 2048 + h * 128, I * 256, p.qk_gain_a, p.qk_gain_a + 128, (const float*)(p.ws + OFF_BIAST) + h * 640);
        } else mem_item(lds, p, 0, it - 768, 3072);
    }
    xcd_barrier(xb);
    gemm_phase<2048, 2, 3>(lds, p);
    xcd_barrier(xb);
    gemm_phase<2048, 1, 5>(lds, p);
    xcd_barrier(xb);
    gemm_phase<8192, 2, 6>(lds, p);
    xcd_barrier(xb);
    gemm_phase<2048, 3, 8>(lds, p);
    xcd_barrier(xb);
    for (;;) {
        LAS int* slot = (LAS int*)(lds + STAGE_BYTES + 64);
        if (tid == 0) slot[0] = (int)atomicAdd(ctr, 1u);
        __syncthreads();
        const int it = slot[0];
        __syncthreads();
        if (it >= 1024) break;
        if (it < 768) {
            const int I = 7 - it / 96, bh = it % 96, b = bh / 12, h = bh % 12;
            const bf16_t* QK = (const bf16_t*)(p.ws + OFF_QK) + (size_t)b * 2048 * 3584;
            attn_item<2>(lds, QK + h * 128, 3584, QK + 2048 + h * 128, 3584,
                         (const bf16_t*)(p.ws + OFF_VT) + (size_t)h * 128 * 16384 + b * 2048, 16384,
                         (bf16_t*)(p.ws + OFF_YCAT) + (size_t)b * 2048 * 2048 + h * 128, I * 256, nullptr, nullptr, nullptr);
        } else mem_item(lds, p, 1, it - 768, 1536);
    }
    xcd_barrier(xb);
    gemm_phase<2048, 2, 10>(lds, p);
    xcd_barrier(xb);
    gemm_phase<2048, 1, 12>(lds, p);
    xcd_barrier(xb);
    gemm_phase<8192, 2, 13>(lds, p);
}

extern "C" void kernel_launch(void* const* d_in, const int* in_sizes, int n_in, void* d_out, int out_size, void* d_ws, size_t ws_size, hipStream_t stream) {
    static int grid_blocks = 0;
    if (!grid_blocks) {
        int dev = 0, cus = 0, per_cu = 0;
        hipGetDevice(&dev);
        hipDeviceGetAttribute(&cus, hipDeviceAttributeMultiprocessorCount, dev);
        hipFuncSetAttribute((const void*)mega, hipFuncAttributeMaxDynamicSharedMemorySize, LDS_BYTES);
        hipOccupancyMaxActiveBlocksPerMultiprocessor(&per_cu, mega, 512, LDS_BYTES);
        if (per_cu < 1) per_cu = 1;
        grid_blocks = cus * per_cu;
        if (grid_blocks > 256) grid_blocks = 256;
    }
    if (ws_size < WS_NEED) { fprintf(stderr, "workspace too small: %zu < %zu\n", ws_size, WS_NEED); return; }
    Params p{};
    p.x = (const float*)d_in[0]; p.mem = (const float*)d_in[1]; p.norm_attn = (const float*)d_in[2]; p.norm_mem = (const float*)d_in[3];
    p.norm_mlp = (const float*)d_in[4]; p.w_in_a = (const float*)d_in[5]; p.qk_gain_a = (const float*)d_in[6]; p.rel_bias = (const float*)d_in[7];
    p.norm_kv = (const float*)d_in[8]; p.w_kv_shared = (const float*)d_in[9]; p.w_q_b = (const float*)d_in[10]; p.w_mem_kv = (const float*)d_in[11];
    p.qk_gain_mem = (const float*)d_in[12]; p.w_o = (const float*)d_in[13]; p.w_mlp_in = (const float*)d_in[14]; p.w_mlp_out = (const float*)d_in[15];
    p.out = (float*)d_out; p.ws = (unsigned char*)d_ws;
    (void)hipMemsetAsync((unsigned char*)d_ws + OFF_CTR, 0, ZERO_BYTES, stream);
    void* args[] = {&p};
    hipError_t e = hipLaunchCooperativeKernel((void*)mega, dim3(grid_blocks), dim3(512), args, LDS_BYTES, stream);
    if (e != hipSuccess) fprintf(stderr, "cooperative launch failed: %s (grid %d)\n", hipGetErrorString(e), grid_blocks);
}
```

```cpp
#include <hip/hip_runtime.h>
#include <hip/hip_cooperative_groups.h>
#include <cstdio>
namespace cg = cooperative_groups;

#define LAS __attribute__((address_space(3)))
#define DI __device__ __forceinline__
typedef unsigned short bf16_t;
typedef short bf16x8 __attribute__((ext_vector_type(8)));
typedef float f32x2 __attribute__((ext_vector_type(2)));
typedef float f32x4 __attribute__((ext_vector_type(4)));
typedef float f32x16 __attribute__((ext_vector_type(16)));
typedef unsigned u32x2 __attribute__((ext_vector_type(2)));
typedef unsigned u32x4 __attribute__((ext_vector_type(4)));
typedef __bf16 bf16v2 __attribute__((ext_vector_type(2)));

constexpr size_t MiB = (size_t)1 << 20;
constexpr size_t OFF_WT_INA    = 0;
constexpr size_t OFF_WT_B1     = 20 * MiB;
constexpr size_t OFF_WT_MEMKV  = 40 * MiB;
constexpr size_t OFF_WT_O      = 48 * MiB;
constexpr size_t OFF_WT_MLPIN  = 64 * MiB;
constexpr size_t OFF_WT_MLPOUT = 128 * MiB;
constexpr size_t OFF_RA        = 192 * MiB;
constexpr size_t OFF_RB        = 256 * MiB;
constexpr size_t OFF_QK        = OFF_RB;
constexpr size_t OFF_VT        = OFF_RB + 112 * MiB;
constexpr size_t OFF_MEMN      = OFF_RB + 160 * MiB;
constexpr size_t OFF_YCAT      = OFF_RB + 176 * MiB;
constexpr size_t OFF_KM        = 512 * MiB;
constexpr size_t OFF_VMT       = 516 * MiB;
constexpr size_t OFF_BIAST     = 520 * MiB;
constexpr size_t OFF_CTR       = 520 * MiB + 32768;
constexpr size_t OFF_BAR       = OFF_CTR + 1024;
constexpr size_t OFF_SS        = OFF_CTR + 16384;
constexpr size_t ZERO_BYTES    = 16384 + 3 * 16384 * 4;
constexpr size_t WS_NEED       = 520 * MiB + 32768 + 16384 + 3 * 16384 * 4;

constexpr float EPS = 1e-6f;
constexpr float LOG2E = 1.4426950408889634f;
constexpr float LN2 = 0.6931471805599453f;
constexpr float ATT_SCALE = 0.08838834764831845f;
constexpr float SB_DONE = 160.0f;

struct Params {
    const float *x, *mem, *norm_attn, *norm_mem, *norm_mlp, *w_in_a, *qk_gain_a, *rel_bias, *norm_kv, *w_kv_shared, *w_q_b, *w_mem_kv,
        *qk_gain_mem, *w_o, *w_mlp_in, *w_mlp_out;
    float* out;
    unsigned char* ws;
};

DI unsigned pack_bf16(float lo, float hi) { f32x2 f = {lo, hi}; bf16v2 b = __builtin_convertvector(f, bf16v2); return __builtin_bit_cast(unsigned, b); }
template <int CTRL> DI float dpp_f(float x) { return __builtin_bit_cast(float, __builtin_amdgcn_mov_dpp(__builtin_bit_cast(int, x), CTRL, 0xf, 0xf, true)); }
DI float dpp_sum16(float x) { x += dpp_f<0xB1>(x); x += dpp_f<0x4E>(x); x += dpp_f<0x141>(x); x += dpp_f<0x128>(x); return x; }
DI float bf2f(short s) { return __uint_as_float(((unsigned)(unsigned short)s) << 16); }
DI bf16x8 pack8(const float* f) {
    u32x4 p; p.x = pack_bf16(f[0], f[1]); p.y = pack_bf16(f[2], f[3]); p.z = pack_bf16(f[4], f[5]); p.w = pack_bf16(f[6], f[7]);
    return __builtin_bit_cast(bf16x8, p);
}

constexpr int BM = 256, BK = 64, HALF = 128, HTB = HALF * BK * 2, STAGE_BYTES = 8 * HTB;
DI int lds_byte(int r, int c) { const int st = (r >> 4) * 2 + (c >> 5), rr = r & 15, cc = c & 31, ob = rr * 64 + cc * 2; return st * 1024 + (ob ^ (((ob >> 9) & 1) << 5)); }
DI void stage_rc(int b, int& R, int& C) { const int st = b / 1024, sb = b % 1024, swz = sb ^ (((sb >> 9) & 1) << 5); R = (st >> 1) * 16 + swz / 64; C = (st & 1) * 32 + (swz % 64) / 2; }
DI int perm32(int rho) { const int n = rho >> 4, i = rho & 15; return 8 * (i >> 2) + 4 * n + (i & 3); }

struct Unit { const char* A; const char* B; char* out; const char* base; bf16_t* hb; float* ss; int ldc, row0, col0, flag; };

DI void tile_map(int wgid, int nM, int nN, int& pm, int& pn) {
    const int nwg = nM * nN;
    { const int q = nwg / 8, r = nwg % 8, xcd = wgid % 8, off = wgid / 8; wgid = (xcd < r ? xcd * (q + 1) : r * (q + 1) + (xcd - r) * q) + off; }
    const int nig = 8 * nN, gid = wgid / nig, fm = gid * 8, gsz = (nM - fm) < 8 ? (nM - fm) : 8;
    pm = fm + ((wgid % nig) % gsz); pn = (wgid % nig) / gsz;
}
DI void mk_unit(Unit& u, const bf16_t* A, const bf16_t* Bt, int K, int nM, int nN, int wg, void* out, const void* base, int ldc, bf16_t* hb = nullptr, float* ss = nullptr, int flag = 0) {
    int pm, pn; tile_map(wg, nM, nN, pm, pn); u.hb = hb; u.ss = ss; u.flag = flag;
    u.A = (const char*)A + (size_t)pm * 256 * K * 2; u.B = (const char*)Bt + (size_t)pn * 256 * K * 2;
    u.out = (char*)out; u.base = (const char*)base; u.ldc = ldc; u.row0 = pm * 256; u.col0 = pn * 256;
}

template <int PH> DI bool sched_next(const Params& p, int i, Unit& u) {
    const int L = i * (int)gridDim.x + (int)blockIdx.x;
    bf16_t* RA = (bf16_t*)(p.ws + OFF_RA);
    if constexpr (PH == 1) {
        bf16_t* W = (bf16_t*)(p.ws + OFF_WT_INA); bf16_t* WM = (bf16_t*)(p.ws + OFF_WT_MEMKV); bf16_t* memn = (bf16_t*)(p.ws + OFF_MEMN);
        if (L < 896) mk_unit(u, RA, W, 2048, 64, 14, L, p.ws + OFF_QK, nullptr, 3584);
        else if (L < 1280) mk_unit(u, W + (size_t)3584 * 2048, RA, 2048, 6, 64, L - 896, p.ws + OFF_VT, nullptr, 16384);
        else if (L < 1344) {
            int j = L - 1280; const int l = j >> 5; j &= 31;
            if (j < 16) mk_unit(u, memn, WM + (size_t)l * 1024 * 2048, 2048, 8, 2, j, p.ws + OFF_KM + (size_t)l * 2048 * 512 * 2, nullptr, 512);
            else mk_unit(u, WM + (size_t)l * 1024 * 2048 + (size_t)512 * 2048, memn, 2048, 2, 8, j - 16, p.ws + OFF_VMT + (size_t)l * 512 * 2048 * 2, nullptr, 2048);
        } else return false;
        return true;
    } else if constexpr (PH == 8) {
        bf16_t* W = (bf16_t*)(p.ws + OFF_WT_B1);
        float* ss = (float*)(p.ws + OFF_SS) + 16384;
        if (L < 896) mk_unit(u, RA, W, 2048, 64, 14, L, p.ws + OFF_QK, nullptr, 3584, nullptr, ss, 0);
        else if (L < 1280) mk_unit(u, W + (size_t)3584 * 2048, RA, 2048, 6, 64, L - 896, p.ws + OFF_VT, nullptr, 16384, nullptr, ss, 1);
        else return false;
        return true;
    } else if constexpr (PH == 3 || PH == 10) {
        constexpr int l = PH == 3 ? 0 : 1;
        if (L >= 512) return false;
        mk_unit(u, (bf16_t*)(p.ws + OFF_YCAT), (bf16_t*)(p.ws + OFF_WT_O) + (size_t)l * 2048 * 2048, 2048, 64, 8, L, p.out, l == 0 ? (const void*)p.x : (const void*)RA, 2048,
                RA, (float*)(p.ws + OFF_SS) + (l == 0 ? 0 : 2 * 16384), l == 0 ? 0 : 1);
        return true;
    } else if constexpr (PH == 5 || PH == 12) {
        constexpr int l = PH == 5 ? 0 : 1;
        if (L >= 2048) return false;
        mk_unit(u, RA, (bf16_t*)(p.ws + OFF_WT_MLPIN) + (size_t)l * 8192 * 2048, 2048, 64, 32, L, p.ws + OFF_RB, nullptr, 8192, nullptr, (float*)(p.ws + OFF_SS) + (l == 0 ? 0 : 2 * 16384));
        return true;
    } else {
        constexpr int l = PH == 6 ? 0 : 1;
        if (L >= 512) return false;
        mk_unit(u, (bf16_t*)(p.ws + OFF_RB), (bf16_t*)(p.ws + OFF_WT_MLPOUT) + (size_t)l * 2048 * 8192, 8192, 64, 8, L, p.out, RA, 2048,
                l == 0 ? RA : nullptr, l == 0 ? (float*)(p.ws + OFF_SS) + 16384 : nullptr, l == 0 ? 1 : 3);
        return true;
    }
}

DI float rs_of(float ssv) { return rsqrtf(ssv * (1.0f / 2048.0f) + EPS); }
template <int MODE>
DI void epilogue(const f32x4 (&acc)[2][2][4][2], const Unit& u, int wr, int wc, int fr, int fq, const float (&ssr)[8]) {
    const int row0 = u.row0 + wr * 64 + fr, col0 = u.col0 + wc * 32 + 8 * fq;
    f32x4 cs[2][2];
    float rrs[8];
    if constexpr (MODE == 3) {
        if (u.flag) {
#pragma unroll
            for (int bj = 0; bj < 2; ++bj)
#pragma unroll
                for (int n = 0; n < 2; ++n) { const f32x4 t = *(const f32x4*)(u.ss + col0 + bj * HALF + 4 * n);
#pragma unroll
                    for (int j = 0; j < 4; ++j) cs[bj][n][j] = rs_of(t[j]); }
        } else {
#pragma unroll
            for (int it = 0; it < 8; ++it) rrs[it] = rs_of(ssr[it]);
        }
    }
    float qs[8];
#pragma unroll
    for (int it = 0; it < 8; ++it) qs[it] = 0.f;
    const bool bbf = (u.flag & 1) != 0;
    u32x4 nb[2]; f32x4 nf[2][2];
    if constexpr (MODE == 2) {
        const size_t roff = (size_t)row0 * u.ldc + col0;
        if (bbf) { nb[0] = *(const u32x4*)((const bf16_t*)u.base + roff); nb[1] = *(const u32x4*)((const bf16_t*)u.base + roff + HALF); }
        else { const float* bp = (const float*)u.base + roff; nf[0][0] = *(const f32x4*)bp; nf[0][1] = *(const f32x4*)(bp + 4); nf[1][0] = *(const f32x4*)(bp + HALF); nf[1][1] = *(const f32x4*)(bp + HALF + 4); }
    }
#pragma unroll
    for (int ai = 0; ai < 2; ++ai)
#pragma unroll
        for (int m = 0; m < 4; ++m) {
            const int it = ai * 4 + m;
            const int row = row0 + ai * HALF + m * 16;
            const size_t roff = (size_t)row * u.ldc + col0;
            float rr = 1.f; float& q = qs[it];
            if constexpr (MODE == 3) { if (!u.flag) rr = rrs[it]; }
            u32x4 cb[2]; f32x4 cf[2][2];
            if constexpr (MODE == 2) {
                cb[0] = nb[0]; cb[1] = nb[1]; cf[0][0] = nf[0][0]; cf[0][1] = nf[0][1]; cf[1][0] = nf[1][0]; cf[1][1] = nf[1][1];
                if (it < 7) {
                    const int nrow = row0 + ((it + 1) >> 2) * HALF + ((it + 1) & 3) * 16;
                    const size_t nroff = (size_t)nrow * u.ldc + col0;
                    if (bbf) { nb[0] = *(const u32x4*)((const bf16_t*)u.base + nroff); nb[1] = *(const u32x4*)((const bf16_t*)u.base + nroff + HALF); }
                    else { const float* bp = (const float*)u.base + nroff; nf[0][0] = *(const f32x4*)bp; nf[0][1] = *(const f32x4*)(bp + 4); nf[1][0] = *(const f32x4*)(bp + HALF); nf[1][1] = *(const f32x4*)(bp + HALF + 4); }
                }
            }
#pragma unroll
            for (int bj = 0; bj < 2; ++bj) {
                f32x4 v0 = acc[ai][bj][m][0], v1 = acc[ai][bj][m][1];
                if constexpr (MODE == 2) {
                    if (bbf) {
                        const u32x4 bb = cb[bj];
                        v0[0] += __uint_as_float(bb.x << 16); v0[1] += __uint_as_float(bb.x & 0xffff0000u); v0[2] += __uint_as_float(bb.y << 16); v0[3] += __uint_as_float(bb.y & 0xffff0000u);
                        v1[0] += __uint_as_float(bb.z << 16); v1[1] += __uint_as_float(bb.z & 0xffff0000u); v1[2] += __uint_as_float(bb.w << 16); v1[3] += __uint_as_float(bb.w & 0xffff0000u);
                    } else { v0 += cf[bj][0]; v1 += cf[bj][1]; }
                    if (u.flag & 2) { float* op = (float*)u.out + roff + bj * HALF; *(f32x4*)op = v0; *(f32x4*)(op + 4) = v1; }
                    if (u.hb) {
                        u32x4 w; w.x = pack_bf16(v0[0], v0[1]); w.y = pack_bf16(v0[2], v0[3]); w.z = pack_bf16(v1[0], v1[1]); w.w = pack_bf16(v1[2], v1[3]);
                        *(u32x4*)(u.hb + roff + bj * HALF) = w;
#pragma unroll
                        for (int j = 0; j < 4; ++j) q += v0[j] * v0[j] + v1[j] * v1[j];
                    }
                } else {
                    if constexpr (MODE == 3) {
                        if (u.flag) { v0 *= cs[bj][0]; v1 *= cs[bj][1]; } else { v0 *= rr; v1 *= rr; }
                    }
                    u32x4 w; w.x = pack_bf16(v0[0], v0[1]); w.y = pack_bf16(v0[2], v0[3]); w.z = pack_bf16(v1[0], v1[1]); w.w = pack_bf16(v1[2], v1[3]);
                    *(u32x4*)((bf16_t*)u.out + roff + bj * HALF) = w;
                }
            }
        }
    if constexpr (MODE == 2) {
        if (u.hb) {
#pragma unroll
            for (int it = 0; it < 8; ++it) qs[it] += __shfl_xor(qs[it], 16);
#pragma unroll
            for (int it = 0; it < 8; ++it) qs[it] += __shfl_xor(qs[it], 32);
            if (fq == 0) {
#pragma unroll
                for (int it = 0; it < 8; ++it) unsafeAtomicAdd(u.ss + row0 + (it >> 2) * HALF + (it & 3) * 16, qs[it]);
            }
        }
    }
}

constexpr int EPI_OFF = STAGE_BYTES + 256, EPI_ROW_B = 144, EPI_WAVE_B = 16 * EPI_ROW_B;
DI void epilogue_rows(const f32x4 (&acc)[2][2][4][2], const Unit& u, int wr, int wc, int fr, int fq, LAS unsigned char* patch, int lane, const float (&ssr)[8]) {
    const int row0 = u.row0 + wr * 64, col0 = u.col0 + wc * 64;
    float rrs[8];
#pragma unroll
    for (int it = 0; it < 8; ++it) { const float t = rs_of(ssr[it]); rrs[it] = t * t; }
#pragma unroll
    for (int ai = 0; ai < 2; ++ai)
#pragma unroll
        for (int m = 0; m < 4; ++m) {
            const int rbase = row0 + ai * HALF + m * 16;
            const float rr = rrs[ai * 4 + m];
#pragma unroll
            for (int bj = 0; bj < 2; ++bj) {
                f32x4 v0 = acc[ai][bj][m][0], v1 = acc[ai][bj][m][1];
#pragma unroll
                for (int j = 0; j < 4; ++j) { float a = fmaxf(v0[j], 0.f), b = fmaxf(v1[j], 0.f); v0[j] = a * a * rr; v1[j] = b * b * rr; }
                u32x4 w; w.x = pack_bf16(v0[0], v0[1]); w.y = pack_bf16(v0[2], v0[3]); w.z = pack_bf16(v1[0], v1[1]); w.w = pack_bf16(v1[2], v1[3]);
                *(LAS u32x4*)(patch + fr * EPI_ROW_B + (32 * bj + 8 * fq) * 2) = w;
            }
#pragma unroll
            for (int i = 0; i < 2; ++i) {
                const int pc = lane + 64 * i, row = pc >> 3, ch = pc & 7;
                const u32x4 w = *(const LAS u32x4*)(patch + row * EPI_ROW_B + ch * 16);
                __builtin_nontemporal_store(w, (u32x4*)((bf16_t*)u.out + (size_t)(rbase + row) * u.ldc + col0 + ch * 8));
            }
        }
}

template <int K, int MODE, int PH>
DI void gemm_phase(LAS unsigned char* lds, const Params& p) {
    int tid = threadIdx.x; asm volatile("" : "+v"(tid));
    const int wid = __builtin_amdgcn_readfirstlane(tid >> 6), lane = tid & 63, wr = wid >> 2, wc = wid & 3, fr = lane & 15, fq = lane >> 4;
    constexpr int nt = K / BK;
    constexpr bool REMAP = (MODE == 1);
    unsigned voffA[2], voffB0[2], voffB1[2];
#pragma unroll
    for (int i = 0; i < 2; ++i) { int R, C; stage_rc(tid * 16 + i * 8192, R, C);
        voffA[i] = (unsigned)(R * K + C) * 2u;
        if constexpr (REMAP) { const int Rb = 64 * (R >> 5) + perm32(R & 31); voffB0[i] = (unsigned)(Rb * K + C) * 2u; voffB1[i] = (unsigned)((Rb + 32) * K + C) * 2u; }
        else { const int Rb = (R & ~31) + perm32(R & 31); voffB0[i] = (unsigned)(Rb * K + C) * 2u; voffB1[i] = (unsigned)((Rb + HALF) * K + C) * 2u; } }
    constexpr size_t kstep = (size_t)(BK * 2);
    constexpr size_t hstep = (size_t)HALF * K * 2;
    const unsigned ldsw = (unsigned)wid * 1024u;
    const int aoff = lds_byte(wr * 64 + fr, fq * 8), boff = lds_byte(wc * 32 + fr, fq * 8);
#define PG8_SA(b, h) (((b) * 2 + (h)) * HTB)
#define PG8_SB(b, h) ((4 + (b) * 2 + (h)) * HTB)
#define PG8_STAGE(bufoff, gbase, voff) do { _Pragma("unroll") for (int _i = 0; _i < 2; ++_i) \
        __builtin_amdgcn_global_load_lds((const unsigned*)((const char*)(gbase) + (voff)[_i]), (LAS unsigned*)(lds + (bufoff) + ldsw + _i * 8192), 16, 0, 0); } while (0)
#define PG8_LDA(dst, b, h) do { _Pragma("unroll") for (int m = 0; m < 4; ++m) _Pragma("unroll") for (int k = 0; k < 2; ++k) dst[m][k] = *(const LAS bf16x8*)(lds + PG8_SA(b, h) + aoff + m * 2048 + k * 1024); } while (0)
#define PG8_LDB(dst, b, h) do { _Pragma("unroll") for (int n = 0; n < 2; ++n) _Pragma("unroll") for (int k = 0; k < 2; ++k) dst[n][k] = *(const LAS bf16x8*)(lds + PG8_SB(b, h) + boff + n * 2048 + k * 1024); } while (0)
#define PG8_MMA(ai, bj, At, Bt) do { __builtin_amdgcn_s_setprio(1); _Pragma("unroll") for (int m = 0; m < 4; ++m) _Pragma("unroll") for (int n = 0; n < 2; ++n) _Pragma("unroll") for (int k = 0; k < 2; ++k) \
        acc[ai][bj][m][n] = __builtin_amdgcn_mfma_f32_16x16x32_bf16(Bt[n][k], At[m][k], acc[ai][bj][m][n], 0, 0, 0); __builtin_amdgcn_s_setprio(0); } while (0)
#define PG8_WAIT_V(n) asm volatile("s_waitcnt vmcnt(" #n ")" ::: "memory")
#define PG8_WAIT_L(n) asm volatile("s_waitcnt lgkmcnt(" #n ")" ::: "memory")
#define PG8_BAR __builtin_amdgcn_s_barrier()
#define PG8_SCHED __builtin_amdgcn_sched_barrier(0)
    Unit cur, nxt; int ui = 0;
    if (!sched_next<PH>(p, 0, cur)) return;
    f32x4 acc[2][2][4][2];
#pragma unroll
    for (int a = 0; a < 2; ++a)
#pragma unroll
        for (int b = 0; b < 2; ++b)
#pragma unroll
            for (int m = 0; m < 4; ++m)
#pragma unroll
                for (int n = 0; n < 2; ++n) acc[a][b][m][n] = (f32x4){0.f, 0.f, 0.f, 0.f};
    bf16x8 At[4][2], B0[2][2], B1[2][2];
    const char* cA = cur.A; const char* cB = cur.B;
    PG8_STAGE(PG8_SB(0, 0), cB, voffB0); PG8_STAGE(PG8_SA(0, 0), cA, voffA); PG8_STAGE(PG8_SB(0, 1), cB, voffB1); PG8_STAGE(PG8_SA(0, 1), cA + hstep, voffA);
    if (wr == 1) PG8_BAR;
    PG8_WAIT_V(4); PG8_BAR;
    PG8_STAGE(PG8_SB(1, 0), cB + kstep, voffB0); PG8_STAGE(PG8_SA(1, 0), cA + kstep, voffA); PG8_STAGE(PG8_SB(1, 1), cB + kstep, voffB1);
    PG8_WAIT_V(6); PG8_BAR;
    for (;;) {
        const bool has_next = sched_next<PH>(p, ui + 1, nxt);
        float ssr[8];
        if constexpr (MODE == 1 || MODE == 3) {
            if (MODE == 1 || !cur.flag) {
#pragma unroll
                for (int it = 0; it < 8; ++it) ssr[it] = cur.ss[cur.row0 + wr * 64 + (it >> 2) * HALF + (it & 3) * 16 + fr];
            } else {
#pragma unroll
                for (int it = 0; it < 8; ++it) ssr[it] = 0.f;
            }
        } else {
#pragma unroll
            for (int it = 0; it < 8; ++it) ssr[it] = 0.f;
        }
        const char* nA = has_next ? nxt.A : cA; const char* nB = has_next ? nxt.B : cB;
        for (int t = 0; t < nt; t += 2) {
            const bool last = (t == nt - 2);
            const char* a1 = cA + (size_t)(t + 1) * kstep;
            const char* a2 = last ? nA : cA + (size_t)(t + 2) * kstep; const char* b2 = last ? nB : cB + (size_t)(t + 2) * kstep;
            const char* a3 = a2 + kstep; const char* b3 = b2 + kstep;
            PG8_LDB(B0, 0, 0); PG8_SCHED; PG8_LDA(At, 0, 0); PG8_STAGE(PG8_SA(1, 1), a1 + hstep, voffA);
            PG8_WAIT_L(8); PG8_BAR; PG8_WAIT_L(0); PG8_MMA(0, 0, At, B0); PG8_BAR; PG8_SCHED;
            PG8_LDB(B1, 0, 1); PG8_STAGE(PG8_SB(0, 0), b2, voffB0);
            PG8_BAR; PG8_WAIT_L(0); PG8_MMA(0, 1, At, B1); PG8_BAR;
            PG8_LDA(At, 0, 1); PG8_STAGE(PG8_SA(0, 0), a2, voffA);
            PG8_BAR; PG8_WAIT_L(0); PG8_MMA(1, 0, At, B0); PG8_BAR; PG8_SCHED;
            PG8_STAGE(PG8_SB(0, 1), b2, voffB1);
            PG8_WAIT_V(6); PG8_BAR; PG8_MMA(1, 1, At, B1); PG8_BAR;
            PG8_LDB(B0, 1, 0); PG8_SCHED; PG8_LDA(At, 1, 0); PG8_STAGE(PG8_SA(0, 1), a2 + hstep, voffA);
            PG8_WAIT_L(8); PG8_BAR; PG8_WAIT_L(0); PG8_MMA(0, 0, At, B0); PG8_BAR; PG8_SCHED;
            PG8_LDB(B1, 1, 1); PG8_STAGE(PG8_SB(1, 0), b3, voffB0);
            PG8_BAR; PG8_WAIT_L(0); PG8_MMA(0, 1, At, B1); PG8_BAR;
            PG8_LDA(At, 1, 1); PG8_STAGE(PG8_SA(1, 0), a3, voffA);
            PG8_BAR; PG8_WAIT_L(0); PG8_MMA(1, 0, At, B0); PG8_BAR; PG8_SCHED;
            PG8_STAGE(PG8_SB(1, 1), b3, voffB1);
            PG8_WAIT_V(6); PG8_BAR; PG8_MMA(1, 1, At, B1); PG8_BAR;
        }
        if constexpr (REMAP) epilogue_rows(acc, cur, wr, wc, fr, fq, lds + EPI_OFF + wid * EPI_WAVE_B, lane, ssr); else epilogue<MODE>(acc, cur, wr, wc, fr, fq, ssr);
        if (!has_next) break;
#pragma unroll
        for (int a = 0; a < 2; ++a)
#pragma unroll
            for (int b = 0; b < 2; ++b)
#pragma unroll
                for (int m = 0; m < 4; ++m)
#pragma unroll
                    for (int n = 0; n < 2; ++n) acc[a][b][m][n] = (f32x4){0.f, 0.f, 0.f, 0.f};
        cur = nxt; cA = nA; cB = nB; ++ui;
    }
    PG8_WAIT_V(0);
    if (wr == 0) PG8_BAR;
    PG8_BAR;
#undef PG8_SA
#undef PG8_SB
#undef PG8_STAGE
#undef PG8_LDA
#undef PG8_LDB
#undef PG8_MMA
#undef PG8_WAIT_V
#undef PG8_WAIT_L
#undef PG8_BAR
#undef PG8_SCHED
}

struct CvtDesc { const float* s; bf16_t* dt; const float* g; int ld, K; };
DI CvtDesc cvt_lookup(const Params& p, int t) {
    const float* src; int ld, K = 2048, nct; bf16_t* dst; const float* gain;
    bf16_t* WA = (bf16_t*)(p.ws + OFF_WT_INA); bf16_t* WB = (bf16_t*)(p.ws + OFF_WT_B1);
    if (t < 384) { src = p.w_in_a; ld = 5120; nct = 24; dst = WA; gain = p.norm_attn; }
    else if ((t -= 384) < 64) { src = p.w_in_a + 4608; ld = 5120; nct = 4; dst = WA + (size_t)3072 * 2048; gain = p.norm_attn; }
    else if ((t -= 64) < 192) { src = p.w_in_a + 3072; ld = 5120; nct = 12; dst = WA + (size_t)3584 * 2048; gain = p.norm_attn; }
    else if ((t -= 192) < 256) { src = p.w_q_b; ld = 2048; nct = 16; dst = WB; gain = p.norm_attn + 2048; }
    else if ((t -= 256) < 384) { src = p.w_kv_shared; ld = 3072; nct = 24; dst = WB + (size_t)2048 * 2048; gain = p.norm_kv; }
    else if ((t -= 384) < 256) { const int l = t >> 7; t &= 127; src = p.w_mem_kv + (size_t)l * 2048 * 1024; ld = 1024; nct = 8;
        dst = (bf16_t*)(p.ws + OFF_WT_MEMKV) + (size_t)l * 1024 * 2048; gain = p.norm_mem + l * 2048; }
    else if ((t -= 256) < 512) { const int l = t >> 8; t &= 255; src = p.w_o + (size_t)l * 2048 * 2048; ld = 2048; nct = 16;
        dst = (bf16_t*)(p.ws + OFF_WT_O) + (size_t)l * 2048 * 2048; gain = nullptr; }
    else if ((t -= 512) < 2048) { const int l = t >> 10; t &= 1023; src = p.w_mlp_in + (size_t)l * 2048 * 8192; ld = 8192; nct = 64;
        dst = (bf16_t*)(p.ws + OFF_WT_MLPIN) + (size_t)l * 8192 * 2048; gain = p.norm_mlp + l * 2048; }
    else { t -= 2048; const int l = t >> 10; t &= 1023; src = p.w_mlp_out + (size_t)l * 8192 * 2048; ld = 2048; K = 8192; nct = 16;
        dst = (bf16_t*)(p.ws + OFF_WT_MLPOUT) + (size_t)l * 2048 * 8192; gain = nullptr; }
    int tid = threadIdx.x; asm volatile("" : "+v"(tid));
    const int w = tid >> 6, lane = tid & 63;
    const int kt0 = (t / nct) * 128, nt0 = (t % nct) * 128, k0 = kt0 + w * 16;
    CvtDesc d; d.s = src + (size_t)k0 * ld + nt0 + lane * 2; d.dt = dst + (size_t)nt0 * K + kt0; d.g = gain ? gain + k0 : nullptr; d.ld = ld; d.K = K;
    return d;
}
struct CvtRegs { float a[16], b[16], g[16]; };
DI void cvt_load(const CvtDesc& d, CvtRegs& r) {
#pragma unroll
    for (int kk = 0; kk < 16; ++kk) { const f32x2 v = __builtin_nontemporal_load((const f32x2*)(d.s + (size_t)kk * d.ld)); r.a[kk] = v.x; r.b[kk] = v.y; }
    if (d.g) {
#pragma unroll
        for (int kk = 0; kk < 16; ++kk) r.g[kk] = d.g[kk];
    } else {
#pragma unroll
        for (int kk = 0; kk < 16; ++kk) r.g[kk] = 1.0f;
    }
}
constexpr int CROW_B = 272;
DI void cvt_to_lds(LAS unsigned char* lds, int w, int lane, CvtRegs& r) {
#pragma unroll
    for (int kk = 0; kk < 16; ++kk) { r.a[kk] *= r.g[kk]; r.b[kk] *= r.g[kk]; }
    LAS unsigned char* r0 = lds + (2 * lane) * CROW_B + w * 32;
    *(LAS bf16x8*)r0 = pack8(r.a); *(LAS bf16x8*)(r0 + 16) = pack8(r.a + 8);
    *(LAS bf16x8*)(r0 + CROW_B) = pack8(r.b); *(LAS bf16x8*)(r0 + CROW_B + 16) = pack8(r.b + 8);
}
DI void cvt_store_pass(LAS unsigned char* lds, int tid, bf16_t* dt, int K) {
#pragma unroll
    for (int i = 0; i < 4; ++i) {
        const int pc = tid + 512 * i, row = pc >> 4, ch = pc & 15;
        const bf16x8 v = *(const LAS bf16x8*)(lds + row * CROW_B + ch * 16);
        *(bf16x8*)(dt + (size_t)row * K + ch * 8) = v;
    }
}
DI void convert_seq(LAS unsigned char* lds, const Params& p, int first, int limit, int stride) {
    if (first >= limit) return;
    int tid = threadIdx.x; asm volatile("" : "+v"(tid));
    const int w = tid >> 6, lane = tid & 63;
    CvtRegs rA, rB;
    CvtDesc dA = cvt_lookup(p, first), dB = dA;
    cvt_load(dA, rA);
    if (first + stride < limit) { dB = cvt_lookup(p, first + stride); cvt_load(dB, rB); }
    for (int t = first; t < limit; t += 2 * stride) {
        {
            cvt_to_lds(lds, w, lane, rA);
            bf16_t* dt = dA.dt; const int K = dA.K;
            __syncthreads();
            if (t + 2 * stride < limit) { dA = cvt_lookup(p, t + 2 * stride); cvt_load(dA, rA); }
            cvt_store_pass(lds, tid, dt, K);
            __syncthreads();
        }
        if (t + stride < limit) {
            cvt_to_lds(lds, w, lane, rB);
            bf16_t* dt = dB.dt; const int K = dB.K;
            __syncthreads();
            if (t + 3 * stride < limit) { dB = cvt_lookup(p, t + 3 * stride); cvt_load(dB, rB); }
            cvt_store_pass(lds, tid, dt, K);
            __syncthreads();
        }
    }
}
DI void rowscale(const float* src, bf16_t* dst, int nrows) {
    int tid = threadIdx.x; asm volatile("" : "+v"(tid));
    const int w = tid >> 6, lane = tid & 63;
    for (int row = blockIdx.x * 8 + w; row < nrows; row += gridDim.x * 8) {
        const float* s = src + (size_t)row * 2048;
        f32x4 v[8]; float ss = 0.f;
#pragma unroll
        for (int j = 0; j < 4; ++j) { v[2 * j] = __builtin_nontemporal_load((const f32x4*)(s + (j * 64 + lane) * 8)); v[2 * j + 1] = __builtin_nontemporal_load((const f32x4*)(s + (j * 64 + lane) * 8 + 4)); }
#pragma unroll
        for (int j = 0; j < 8; ++j) ss += v[j][0] * v[j][0] + v[j][1] * v[j][1] + v[j][2] * v[j][2] + v[j][3] * v[j][3];
#pragma unroll
        for (int o = 32; o >= 1; o >>= 1) ss += __shfl_xor(ss, o);
        const float r = rsqrtf(ss * (1.0f / 2048.0f) + EPS);
#pragma unroll
        for (int j = 0; j < 4; ++j) {
            u32x4 o; o.x = pack_bf16(v[2 * j][0] * r, v[2 * j][1] * r); o.y = pack_bf16(v[2 * j][2] * r, v[2 * j][3] * r);
            o.z = pack_bf16(v[2 * j + 1][0] * r, v[2 * j + 1][1] * r); o.w = pack_bf16(v[2 * j + 1][2] * r, v[2 * j + 1][3] * r);
            *(u32x4*)(dst + (size_t)row * 2048 + (j * 64 + lane) * 8) = o;
        }
    }
}

constexpr int KROW_B = 272, VROW_B = 144, KBUF_B = 64 * KROW_B, VBUF_B = 128 * VROW_B, ABUF_B = KBUF_B + VBUF_B, BIAS_OFF = 2 * ABUF_B, OROW_B = 272;
#define MFMA32(a, b, c) __builtin_amdgcn_mfma_f32_32x32x16_bf16((a), (b), (c), 0, 0, 0)

DI void sb_block(const f32x16& st, bool diag, int r, int hh, float& R, float* pv) {
    float sp[16];
    float totA = 0.f, totB = 0.f;
#pragma unroll
    for (int i = 0; i < 16; ++i) {
        const float t = st[i] * (ATT_SCALE * LOG2E);
        const float e = __builtin_amdgcn_exp2f(-fabsf(t));
        float v = fmaxf(t, 0.f) + __builtin_amdgcn_logf(1.0f + e);
        if (diag && !((16 * (i >> 3) + 8 * hh + (i & 7)) < r)) v = 0.f;
        sp[i] = v;
        if (i < 8) totA += v; else totB += v;
    }
    const float oA = __shfl_xor(totA, 32), oB = __shfl_xor(totB, 32);
    float accA = R + (hh == 0 ? (oA + totB + oB) : (oB + totB)), accB = R + (hh == 0 ? oB : 0.f);
#pragma unroll
    for (int i = 7; i >= 0; --i) {
        const float tA = st[i] * (ATT_SCALE * LOG2E), tB = st[8 + i] * (ATT_SCALE * LOG2E);
        float a = __builtin_amdgcn_exp2f(tA - sp[i] - accA), b = __builtin_amdgcn_exp2f(tB - sp[8 + i] - accB);
        accA += sp[i]; accB += sp[8 + i];
        if (diag && !((8 * hh + i) < r)) a = 0.f;
        if (diag && !((16 + 8 * hh + i) < r)) b = 0.f;
        pv[i] = a; pv[8 + i] = b;
    }
    R += (totA + totB) + (oA + oB);
}

template <int MODE>
DI void attn_item(LAS unsigned char* lds, const bf16_t* Qp, int ldq, const bf16_t* Kp, int ldk, const bf16_t* VTp, int ldv, bf16_t* Yp, int q0,
                  const float* gq, const float* gk, const float* biasT_h) {
    int tid = threadIdx.x; asm volatile("" : "+v"(tid));
    const int w = __builtin_amdgcn_readfirstlane(tid >> 6), lane = tid & 63, r = lane & 31, hh = lane >> 5;
    const int rp = (r & ~12) | ((r & 4) << 1) | ((r & 8) >> 1);
    int s_hi, s_lo;
    if constexpr (MODE == 0) { const int n0 = q0 >> 6; s_hi = n0 + 3; s_lo = n0 - 8 > 0 ? n0 - 8 : 0; }
    else if constexpr (MODE == 1) { s_hi = 3; s_lo = 0; }
    else { s_hi = (q0 >> 6) + 3; s_lo = 0; }

    bf16x8 qf[8];
    {
        const bf16_t* qrow = Qp + (size_t)(q0 + w * 32 + r) * ldq + hh * 8;
#pragma unroll
        for (int kk = 0; kk < 8; ++kk) qf[kk] = *(const bf16x8*)(qrow + kk * 16);
        if constexpr (MODE != 2) {
            float ss = 0.f;
#pragma unroll
            for (int kk = 0; kk < 8; ++kk)
#pragma unroll
                for (int j = 0; j < 8; ++j) { const float f = bf2f(qf[kk][j]); ss += f * f; }
            ss += __shfl_xor(ss, 32);
            const float rq = rsqrtf(ss * (1.0f / 128.0f) + EPS) * (ATT_SCALE * LOG2E);
#pragma unroll
            for (int kk = 0; kk < 8; ++kk) {
                const f32x4 g0 = *(const f32x4*)(gq + kk * 16 + hh * 8), g1 = *(const f32x4*)(gq + kk * 16 + hh * 8 + 4);
                float f[8];
#pragma unroll
                for (int j = 0; j < 4; ++j) { f[j] = bf2f(qf[kk][j]) * rq * g0[j]; f[4 + j] = bf2f(qf[kk][4 + j]) * rq * g1[j]; }
                qf[kk] = pack8(f);
            }
        }
    }
    const int krow = tid >> 4, kc16 = tid & 15, vrow = tid >> 3, vc16 = tid & 7;
    f32x4 gk0 = {1.f, 1.f, 1.f, 1.f}, gk1 = gk0;
    if constexpr (MODE != 2) { gk0 = *(const f32x4*)(gk + kc16 * 8); gk1 = *(const f32x4*)(gk + kc16 * 8 + 4); }
    const bf16_t* kg = Kp + (size_t)krow * ldk + kc16 * 8;
    const bf16_t* vg = VTp + (size_t)vrow * ldv + vc16 * 8;
    const unsigned kst = krow * KROW_B + kc16 * 16, vst = KBUF_B + vrow * VROW_B + vc16 * 16;
    if constexpr (MODE == 0) { LAS float* bl = (LAS float*)(lds + BIAS_OFF); for (int i = tid; i < 640; i += 512) bl[i] = biasT_h[i]; }
    LAS int* sbflag = (LAS int*)(lds + BIAS_OFF);
    if constexpr (MODE == 2) { if (tid < 16) sbflag[tid] = 0; }
    bool wave_done = false;

    f32x16 o[4];
#pragma unroll
    for (int d = 0; d < 4; ++d)
#pragma unroll
        for (int i = 0; i < 16; ++i) o[d][i] = 0.f;
    float m_run = -1e30f, l_run = 0.f, R = 0.f;

    bf16x8 kreg[2], vreg[2];
#pragma unroll
    for (int i = 0; i < 2; ++i) { kreg[i] = *(const bf16x8*)(kg + (size_t)(s_hi * 64 + i * 32) * ldk); vreg[i] = *(const bf16x8*)(vg + (size_t)(i * 64) * ldv + s_hi * 64); }
    for (int s = s_hi; s >= s_lo; --s) {
        const int buf = (s_hi - s) & 1;
        LAS unsigned char* B = lds + buf * ABUF_B;
#pragma unroll
        for (int i = 0; i < 2; ++i) {
            if constexpr (MODE != 2) {
                float f[8]; float ss = 0.f;
#pragma unroll
                for (int j = 0; j < 8; ++j) { f[j] = bf2f(kreg[i][j]); ss += f[j] * f[j]; }
                ss = dpp_sum16(ss);
                const float rk = rsqrtf(ss * (1.0f / 128.0f) + EPS);
#pragma unroll
                for (int j = 0; j < 4; ++j) { f[j] *= rk * gk0[j]; f[4 + j] *= rk * gk1[j]; }
                kreg[i] = pack8(f);
            }
            *(LAS bf16x8*)(B + kst + i * 32 * KROW_B) = kreg[i]; *(LAS bf16x8*)(B + vst + i * 64 * VROW_B) = vreg[i];
        }
        __syncthreads();
        if constexpr (MODE == 2) {
            int alldone = 1;
#pragma unroll
            for (int i = 0; i < 8; ++i) alldone &= sbflag[buf * 8 + i];
            if (alldone) break;
        }
        if (s > s_lo) {
#pragma unroll
            for (int i = 0; i < 2; ++i) { kreg[i] = *(const bf16x8*)(kg + (size_t)((s - 1) * 64 + i * 32) * ldk); vreg[i] = *(const bf16x8*)(vg + (size_t)(i * 64) * ldv + (s - 1) * 64); }
        }
        bool active;
        if constexpr (MODE == 0) { const int c = (q0 >> 6) + (w >> 1); active = (s >= c - 8) && (s <= c); }
        else if constexpr (MODE == 1) active = true;
        else active = (s <= (q0 >> 6) + (w >> 1)) && !wave_done;
        if (active) {
            float pv[32];
            bool both = true;
            if constexpr (MODE == 2) both = (2 * s + 1) <= (q0 >> 5) + w;
            const LAS unsigned char* Kb = B + rp * KROW_B + hh * 16;
            const LAS unsigned char* Vb = B + KBUF_B + r * VROW_B + hh * 16;
            f32x16 st0, st1;
#pragma unroll
            for (int i = 0; i < 16; ++i) { st0[i] = 0.f; st1[i] = 0.f; }
            if (both) {
                bf16x8 fa[8], fb[8];
#pragma unroll
                for (int kk = 0; kk < 8; ++kk) fa[kk] = *(const LAS bf16x8*)(Kb + kk * 32);
                __builtin_amdgcn_sched_barrier(0);
#pragma unroll
                for (int kk = 0; kk < 8; ++kk) fb[kk] = *(const LAS bf16x8*)(Kb + 32 * KROW_B + kk * 32);
#pragma unroll
                for (int kk = 0; kk < 8; ++kk) st0 = MFMA32(fa[kk], qf[kk], st0);
                __builtin_amdgcn_sched_barrier(0);
                constexpr int JA = (MODE == 2) ? 1 : 0, JB = 1 - JA;
#pragma unroll
                for (int d = 0; d < 4; ++d)
#pragma unroll
                    for (int ks = 0; ks < 2; ++ks) fa[d * 2 + ks] = *(const LAS bf16x8*)(Vb + d * 32 * VROW_B + JA * 64 + ks * 32);
#pragma unroll
                for (int kk = 0; kk < 8; ++kk) st1 = MFMA32(fb[kk], qf[kk], st1);
                __builtin_amdgcn_sched_barrier(0);
#define LOAD_FB() do { _Pragma("unroll") for (int d = 0; d < 4; ++d) _Pragma("unroll") for (int ks = 0; ks < 2; ++ks) \
                    fb[d * 2 + ks] = *(const LAS bf16x8*)(Vb + d * 32 * VROW_B + JB * 64 + ks * 32); } while (0)
                if constexpr (MODE != 2) {
                    float sc[32];
                    if constexpr (MODE == 0) {
                        const LAS float* bl = (const LAS float*)(lds + BIAS_OFF) + ((q0 + w * 32 + r) - s * 64 - 8 * hh + 63);
#pragma unroll
                        for (int i = 0; i < 16; ++i) { sc[i] = st0[i] + bl[-(16 * (i >> 3) + (i & 7))]; sc[16 + i] = st1[i] + bl[-(32 + 16 * (i >> 3) + (i & 7))]; }
                    } else {
#pragma unroll
                        for (int i = 0; i < 16; ++i) { sc[i] = st0[i]; sc[16 + i] = st1[i]; }
                    }
                    float mx = sc[0];
#pragma unroll
                    for (int i = 1; i < 32; ++i) mx = fmaxf(mx, sc[i]);
                    mx = fmaxf(mx, __shfl_xor(mx, 32));
                    const float mnew = fmaxf(m_run, mx);
                    if (__any(mnew > m_run)) {
                        const float alpha = __builtin_amdgcn_exp2f(m_run - mnew);
                        l_run *= alpha;
#pragma unroll
                        for (int d = 0; d < 4; ++d)
#pragma unroll
                            for (int i = 0; i < 16; ++i) o[d][i] *= alpha;
                        m_run = mnew;
                    }
                    float ps = 0.f;
#pragma unroll
                    for (int i = 0; i < 32; ++i) { pv[i] = __builtin_amdgcn_exp2f(sc[i] - m_run); ps += pv[i]; }
                    l_run += ps;
                    const bf16x8 pf0 = pack8(pv), pf1 = pack8(pv + 8), pf2 = pack8(pv + 16), pf3 = pack8(pv + 24);
                    __builtin_amdgcn_sched_barrier(0);
                    LOAD_FB();
#pragma unroll
                    for (int d = 0; d < 4; ++d) { o[d] = MFMA32(fa[d * 2], pf0, o[d]); o[d] = MFMA32(fa[d * 2 + 1], pf1, o[d]); }
                    __builtin_amdgcn_sched_barrier(0);
#pragma unroll
                    for (int d = 0; d < 4; ++d) { o[d] = MFMA32(fb[d * 2], pf2, o[d]); o[d] = MFMA32(fb[d * 2 + 1], pf3, o[d]); }
                } else {
                    const int kdiag = (q0 >> 5) + w;
                    sb_block(st1, (2 * s + 1) == kdiag, r, hh, R, pv + 16);
                    const bf16x8 pf2 = pack8(pv + 16), pf3 = pack8(pv + 24);
#pragma unroll
                    for (int d = 0; d < 4; ++d) { o[d] = MFMA32(fa[d * 2], pf2, o[d]); o[d] = MFMA32(fa[d * 2 + 1], pf3, o[d]); }
                    __builtin_amdgcn_sched_barrier(0);
                    sb_block(st0, false, r, hh, R, pv);
                    const bf16x8 pf0 = pack8(pv), pf1 = pack8(pv + 8);
                    __builtin_amdgcn_sched_barrier(0);
                    LOAD_FB();
#pragma unroll
                    for (int d = 0; d < 4; ++d) { o[d] = MFMA32(fb[d * 2], pf0, o[d]); o[d] = MFMA32(fb[d * 2 + 1], pf1, o[d]); }
                }
#undef LOAD_FB
            } else {
                if constexpr (MODE == 2) {
#pragma unroll
                    for (int kk = 0; kk < 8; ++kk) { const bf16x8 kf = *(const LAS bf16x8*)(Kb + kk * 32); st0 = MFMA32(kf, qf[kk], st0); }
                    sb_block(st0, true, r, hh, R, pv);
                    const bf16x8 pf0 = pack8(pv), pf1 = pack8(pv + 8);
#pragma unroll
                    for (int d = 0; d < 4; ++d) {
                        const bf16x8 v0 = *(const LAS bf16x8*)(Vb + d * 32 * VROW_B), v1 = *(const LAS bf16x8*)(Vb + d * 32 * VROW_B + 32);
                        o[d] = MFMA32(v0, pf0, o[d]); o[d] = MFMA32(v1, pf1, o[d]);
                    }
                }
            }
            if constexpr (MODE == 2) { if (__all(R >= SB_DONE)) wave_done = true; }
        }
        if constexpr (MODE == 2) { if (lane == 0) sbflag[(buf ^ 1) * 8 + w] = wave_done ? 1 : 0; }
    }
    float inv = 1.f;
    if constexpr (MODE != 2) { const float lt = l_run + __shfl_xor(l_run, 32); inv = 1.0f / lt; }
    __syncthreads();
    LAS unsigned char* ob = lds + w * (32 * OROW_B);
#pragma unroll
    for (int d = 0; d < 4; ++d)
#pragma unroll
        for (int g = 0; g < 4; ++g) {
            u32x2 v; v.x = pack_bf16(o[d][4 * g] * inv, o[d][4 * g + 1] * inv); v.y = pack_bf16(o[d][4 * g + 2] * inv, o[d][4 * g + 3] * inv);
            *(LAS u32x2*)(ob + r * OROW_B + (d * 32 + 8 * g + 4 * hh) * 2) = v;
        }
    __syncthreads();
#pragma unroll
    for (int i = 0; i < 8; ++i) {
        const int pc = lane + 64 * i, row = pc >> 4, ch = pc & 15;
        const bf16x8 v = *(const LAS bf16x8*)(ob + row * OROW_B + ch * 16);
        *(bf16x8*)(Yp + (size_t)(q0 + w * 32 + row) * 2048 + ch * 8) = v;
    }
    __syncthreads();
}

DI void mem_item(LAS unsigned char* lds, const Params& p, int l, int j, int qcol0) {
    const int bm = j >> 3, I = j & 7, b = bm >> 2, m = bm & 3;
    const bf16_t* QK = (const bf16_t*)(p.ws + OFF_QK);
    attn_item<1>(lds, QK + (size_t)b * 2048 * 3584 + qcol0 + m * 128, 3584,
                 (const bf16_t*)(p.ws + OFF_KM) + (size_t)l * 2048 * 512 + (size_t)b * 256 * 512 + m * 128, 512,
                 (const bf16_t*)(p.ws + OFF_VMT) + (size_t)l * 512 * 2048 + (size_t)m * 128 * 2048 + b * 256, 2048,
                 (bf16_t*)(p.ws + OFF_YCAT) + (size_t)b * 2048 * 2048 + 1536 + m * 128, I * 256,
                 p.qk_gain_mem + l * 256, p.qk_gain_mem + l * 256 + 128, nullptr);
}


#define XB_TMO      128
#define XB_XCNT(j)  (256  + 64 * (j))
#define XB_XSUB(j)  (1280 + 64 * (j))
#define XB_XGEN(j)  (2304 + 64 * (j))
#define XB_TOP      3328
#define XB_TOPGEN   3392
#define XCD_BAR_WORDS 3456
#define XB_SPIN_CAP (1u << 22)
DI unsigned xb_ld(unsigned* p) { return __hip_atomic_load(p, __ATOMIC_RELAXED, __HIP_MEMORY_SCOPE_AGENT); }
DI unsigned xb_add(unsigned* p, unsigned v) { return __hip_atomic_fetch_add(p, v, __ATOMIC_RELAXED, __HIP_MEMORY_SCOPE_AGENT); }
DI unsigned xb_xcc_id() { return (unsigned)__builtin_amdgcn_s_getreg((3 << 11) | 20) & 0xFu; }
#define XB_SPIN(cond, bar) do { unsigned _sp = 0; while (cond) { __builtin_amdgcn_s_sleep(1); \
    if ((++_sp & 255u) == 0u) { if (xb_ld(&(bar)[XB_TMO])) break; if (_sp > XB_SPIN_CAP) { atomicAdd(&(bar)[XB_TMO], 1u); break; } } } } while (0)
struct XcdBarrier { unsigned* bar; unsigned x; volatile LAS unsigned* st; };
DI XcdBarrier xcd_barrier_post(unsigned* bar, volatile LAS unsigned* st) {
    XcdBarrier b; b.bar = bar; b.x = xb_xcc_id(); b.st = st;
    if (threadIdx.x == 0) (void)xb_add(&bar[XB_XCNT(b.x)], 1u);
    return b;
}
DI void xcd_barrier_complete(unsigned* bar, unsigned x, unsigned& nloc, unsigned& nx) {
    const unsigned G = gridDim.x * gridDim.y * gridDim.z;
    unsigned sum, cnt, mine, sp = 0u;
    for (;;) {
        sum = 0u; cnt = 0u; mine = 0u;
#pragma unroll
        for (unsigned j = 0; j < 16; ++j) { const unsigned c = xb_ld(&bar[XB_XCNT(j)]); sum += c; cnt += (c > 0u) ? 1u : 0u; mine = (j == x) ? c : mine; }
        if (sum == G) break;
        __builtin_amdgcn_s_sleep(1);
        if ((++sp & 255u) == 0u) { if (xb_ld(&bar[XB_TMO])) break; if (sp > XB_SPIN_CAP) { atomicAdd(&bar[XB_TMO], 1u); break; } }
    }
    nloc = mine > 0u ? mine : 1u; nx = cnt > 0u ? cnt : 1u;
}
DI void xcd_barrier(const XcdBarrier& b) {
    asm volatile("s_waitcnt vmcnt(0)" ::: "memory");
    __syncthreads();
    if (threadIdx.x == 0) {
        unsigned* bar = b.bar;
        __builtin_amdgcn_s_waitcnt(0);
        unsigned nloc = b.st[0], nx = b.st[1];
        if (nloc == 0u) { xcd_barrier_complete(bar, b.x, nloc, nx); b.st[0] = nloc; b.st[1] = nx; }
        const unsigned old = xb_add(&bar[XB_XSUB(b.x)], 1u);
        const unsigned gen = old / nloc;
        if (old + 1u == (gen + 1u) * nloc) {
            __builtin_amdgcn_fence(__ATOMIC_RELEASE, "agent");
            asm volatile("s_waitcnt vmcnt(0)" ::: "memory");
            const unsigned og = xb_add(&bar[XB_TOP], 1u);
            const unsigned tg = og / nx;
            if (og + 1u == (tg + 1u) * nx) xb_add(&bar[XB_TOPGEN], 1u);
            else XB_SPIN(xb_ld(&bar[XB_TOPGEN]) == tg, bar);
            __builtin_amdgcn_fence(__ATOMIC_ACQUIRE, "agent");
            xb_add(&bar[XB_XGEN(b.x)], 1u);
            asm volatile("s_waitcnt vmcnt(0)" ::: "memory");
        } else {
            XB_SPIN(xb_ld(&bar[XB_XGEN(b.x)]) == gen, bar);
            __builtin_amdgcn_fence(__ATOMIC_ACQUIRE, "agent");
            asm volatile("s_waitcnt vmcnt(0)" ::: "memory");
        }
    }
    __syncthreads();
}

constexpr int LDS_BYTES = STAGE_BYTES + 256 + 8 * EPI_WAVE_B;

__global__ void __launch_bounds__(512, 2) mega(Params p) {
    extern __shared__ __attribute__((aligned(16))) unsigned char shm_raw[];
    LAS unsigned char* lds = (LAS unsigned char*)shm_raw;
    cg::grid_group grid = cg::this_grid();
    const int tid = threadIdx.x;
    bf16_t* RA = (bf16_t*)(p.ws + OFF_RA);
    unsigned* ctr = (unsigned*)(p.ws + OFF_CTR);
    volatile LAS unsigned* xst = (volatile LAS unsigned*)(lds + STAGE_BYTES);
    if (tid == 0) { xst[0] = 0u; xst[1] = 0u; }
    __syncthreads();
    const XcdBarrier xb = xcd_barrier_post((unsigned*)(p.ws + OFF_BAR), xst);

    convert_seq(lds, p, (int)blockIdx.x, 4096, (int)gridDim.x);
    rowscale(p.x, RA, 16384);
    rowscale(p.mem, (bf16_t*)(p.ws + OFF_MEMN), 2048);
    {
        float* bt = (float*)(p.ws + OFF_BIAST);
        for (int i = blockIdx.x * 512 + tid; i < 12 * 640; i += gridDim.x * 512) {
            const int h = i / 640, idx = i % 640; int dist = idx - 63; if (dist > 256) dist = 256;
            bt[i] = p.rel_bias[(dist + 256) * 12 + h] * LOG2E;
        }
    }
    if (p.ws == nullptr) grid.sync();
    xcd_barrier(xb);
    gemm_phase<2048, 0, 1>(lds, p);
    {
        const int nfree = (int)gridDim.x - 64;
        if (nfree > 0) { if ((int)blockIdx.x >= 64) convert_seq(lds, p, 4096 + (int)blockIdx.x - 64, 6144, nfree); }
        else convert_seq(lds, p, 4096 + (int)blockIdx.x, 6144, (int)gridDim.x);
    }
    xcd_barrier(xb);
    for (int it = blockIdx.x; it < 1024; it += gridDim.x) {
        if (it < 768) {
            const int bh = it >> 3, I = it & 7, b = bh / 12, h = bh % 12;
            const bf16_t* QK = (const bf16_t*)(p.ws + OFF_QK) + (size_t)b * 2048 * 3584;
            attn_item<0>(lds, QK + h * 128, 3584, QK + 1536 + h * 128, 3584,
                         (const bf16_t*)(p.ws + OFF_VT) + (size_t)h * 128 * 16384 + b * 2048, 16384,
                         (bf16_t*)(p.ws + OFF_YCAT) + (size_t)b * 2048 * 2048 + h * 128, I * 256, p.qk_gain_a, p.qk_gain_a + 128, (const float*)(p.ws + OFF_BIAST) + h * 640);
        } else mem_item(lds, p, 0, it - 768, 3072);
    }
    xcd_barrier(xb);
    gemm_phase<2048, 2, 3>(lds, p);
    xcd_barrier(xb);
    gemm_phase<2048, 1, 5>(lds, p);
    xcd_barrier(xb);
    gemm_phase<8192, 2, 6>(lds, p);
    xcd_barrier(xb);
    gemm_phase<2048, 3, 8>(lds, p);
    xcd_barrier(xb);
    for (;;) {
        LAS int* slot = (LAS int*)(lds + STAGE_BYTES + 64);
        if (tid == 0) slot[0] = (int)atomicAdd(ctr, 1u);
        __syncthreads();
        const int it = slot[0];
        __syncthreads();
        if (it >= 1024) break;
        if (it < 768) {
            const int I = 7 - it / 96, bh = it % 96, b = bh / 12, h = bh % 12;
            const bf16_t* QK = (const bf16_t*)(p.ws + OFF_QK) + (size_t)b * 2048 * 3584;
            attn_item<2>(lds, QK + h * 128, 3584, QK + 2048 + h * 128, 3584,
                         (const bf16_t*)(p.ws + OFF_VT) + (size_t)h * 128 * 16384 + b * 2048, 16384,
                         (bf16_t*)(p.ws + OFF_YCAT) + (size_t)b * 2048 * 2048 + h * 128, I * 256, nullptr, nullptr, nullptr);
        } else mem_item(lds, p, 1, it - 768, 1536);
    }
    xcd_barrier(xb);
    gemm_phase<2048, 2, 10>(lds, p);
    xcd_barrier(xb);
    gemm_phase<2048, 1, 12>(lds, p);
    xcd_barrier(xb);
    gemm_phase<8192, 2, 13>(lds, p);
}

extern "C" void kernel_launch(void* const* d_in, const int* in_sizes, int n_in, void* d_out, int out_size, void* d_ws, size_t ws_size, hipStream_t stream) {
    static int grid_blocks = 0;
    if (!grid_blocks) {
        int dev = 0, cus = 0, per_cu = 0;
        hipGetDevice(&dev);
        hipDeviceGetAttribute(&cus, hipDeviceAttributeMultiprocessorCount, dev);
        hipFuncSetAttribute((const void*)mega, hipFuncAttributeMaxDynamicSharedMemorySize, LDS_BYTES);
        hipOccupancyMaxActiveBlocksPerMultiprocessor(&per_cu, mega, 512, LDS_BYTES);
        if (per_cu < 1) per_cu = 1;
        grid_blocks = cus * per_cu;
        if (grid_blocks > 256) grid_blocks = 256;
    }
    if (ws_size < WS_NEED) { fprintf(stderr, "workspace too small: %zu < %zu\n", ws_size, WS_NEED); return; }
    Params p{};
    p.x = (const float*)d_in[0]; p.mem = (const float*)d_in[1]; p.norm_attn = (const float*)d_in[2]; p.norm_mem = (const float*)d_in[3];
    p.norm_mlp = (const float*)d_in[4]; p.w_in_a = (const float*)d_in[5]; p.qk_gain_a = (const float*)d_in[6]; p.rel_bias = (const float*)d_in[7];
    p.norm_kv = (const float*)d_in[8]; p.w_kv_shared = (const float*)d_in[9]; p.w_q_b = (const float*)d_in[10]; p.w_mem_kv = (const float*)d_in[11];
    p.qk_gain_mem = (const float*)d_in[12]; p.w_o = (const float*)d_in[13]; p.w_mlp_in = (const float*)d_in[14]; p.w_mlp_out = (const float*)d_in[15];
    p.out = (float*)d_out; p.ws = (unsigned char*)d_ws;
    (void)hipMemsetAsync((unsigned char*)d_ws + OFF_CTR, 0, ZERO_BYTES, stream);
    void* args[] = {&p};
    hipError_t e = hipLaunchCooperativeKernel((void*)mega, dim3(grid_blocks), dim3(512), args, LDS_BYTES, stream);
    if (e != hipSuccess) fprintf(stderr, "cooperative launch failed: %s (grid %d)\n", hipGetErrorString(e), grid_blocks);
}
```
